# Optimizing an MI355X kernel written in HIP

```python
import math
import jax, jax.numpy as jnp
from jax import lax
import numpy as np

D_MODEL = 2048
BATCH = 2
SEQ = 16384
DEPTH = 2

HEAD_DIM = 128
SGU_GROUPS = 8
SGU_CHUNK = 128
SGU_WIDTH = SGU_GROUPS * HEAD_DIM
NSA_HEADS = 8
NSA_KV_GROUPS = 2
NSA_REP = NSA_HEADS // NSA_KV_GROUPS
NSA_WIDTH = NSA_HEADS * HEAD_DIM
KV_WIDTH = NSA_KV_GROUPS * HEAD_DIM
CMP_LEN = 32
CMP_STRIDE = 16
SLC_LEN = 64
SLC_TOP_N = 16
WINDOW = 512
Q_BLOCK = 128
N_BRANCH = 3
FORCE_SCORE = 1e9
EVEN_IN_WIDTH = 2 * SGU_WIDTH + NSA_WIDTH + 6 * KV_WIDTH + N_BRANCH * NSA_HEADS
EVEN_MIX_WIDTH = SGU_WIDTH + NSA_WIDTH
CONV_WIDTH = D_MODEL
CONV_K = 3
D_FF = -(-8 * D_MODEL // (3 * 256)) * 256
N_EVEN = (DEPTH + 1) // 2
N_ODD = DEPTH // 2
EPS = 1e-6
NEG = -1e30

kernel_name = 'hybrid_sgu_nsa_shortconv_trunk'


def rmsnorm(x, g):
    xf = x.astype(jnp.float32)
    y = xf * lax.rsqrt(jnp.mean(xf * xf, axis=-1, keepdims=True) + EPS)
    return (y * g.astype(jnp.float32)).astype(x.dtype)


def masked_softmax(s, mask):
    s = jnp.where(mask, s.astype(jnp.float32), NEG)
    m = jnp.max(s, axis=-1, keepdims=True)
    p = jnp.exp(s - m) * mask
    return p / jnp.maximum(jnp.sum(p, axis=-1, keepdims=True), 1e-30)


def alibi_slopes(n):
    return 2.0 ** (-8.0 * jnp.arange(1, n + 1, dtype=jnp.float32) / n)


def swiglu(h, w_gate, w_up, w_down):
    return (jax.nn.silu(h @ w_gate) * (h @ w_up)) @ w_down


def compress_blocks(kv, pe, w1, w2):
    b, s, g, d = kv.shape
    r = CMP_LEN // CMP_STRIDE
    n_cmp = s // CMP_STRIDE - (r - 1)
    chunks = kv.reshape(b, s // CMP_STRIDE, CMP_STRIDE, g, d)
    blocks = jnp.concatenate([chunks[:, j:j + n_cmp] for j in range(r)], axis=2)
    blocks = blocks + pe[None, None, :, None, :]
    hid = jax.nn.gelu(jnp.einsum('bnlgd,lde->bnge', blocks, w1))
    return jnp.einsum('bnge,ef->bngf', hid, w2)


def selection_importance(p_cmp, n_slc):
    r1 = SLC_LEN // CMP_STRIDE
    r2 = CMP_LEN // CMP_STRIDE
    n_cmp = p_cmp.shape[-1]
    pad = [(0, 0)] * (p_cmp.ndim - 1) + [(r2 - 1, r1 * n_slc - n_cmp)]
    pp = jnp.pad(p_cmp, pad)
    terms = []
    for m in range(r1):
        for n in range(r2):
            st = m - n + r2 - 1
            terms.append(pp[..., st: st + r1 * (n_slc - 1) + 1: r1])
    return jnp.sum(jnp.stack(terms, axis=0), axis=0)


def nsa_attention(q, k_cmp, v_cmp, k_slc, v_slc, k_win, v_win, gates):
    b, s, g, r, d = q.shape
    n_cmp = k_cmp.shape[1]
    n_slc = s // SLC_LEN
    top_n = min(SLC_TOP_N, n_slc)
    scale = d ** -0.5
    slopes = alibi_slopes(g * r).reshape(g, r)
    cmp_idx = jnp.arange(n_cmp)
    cmp_end = cmp_idx * CMP_STRIDE + CMP_LEN - 1
    cmp_mid = (cmp_idx * CMP_STRIDE).astype(jnp.float32) + (CMP_LEN - 1) / 2
    ks_blocks = k_slc.reshape(b, n_slc, SLC_LEN, g, d).transpose(0, 3, 1, 2, 4)
    vs_blocks = v_slc.reshape(b, n_slc, SLC_LEN, g, d).transpose(0, 3, 1, 2, 4)
    kw_pad = jnp.pad(k_win, ((0, 0), (WINDOW, 0), (0, 0), (0, 0)))
    vw_pad = jnp.pad(v_win, ((0, 0), (WINDOW, 0), (0, 0), (0, 0)))
    b_ix = jnp.arange(b)[:, None, None, None]
    g_ix = jnp.arange(g)[None, :, None, None]
    blk_ids = jnp.arange(n_slc)

    def one_block(qb):
        q0 = qb * Q_BLOCK
        t = q0 + jnp.arange(Q_BLOCK)
        tf = t.astype(jnp.float32)
        qblk = lax.dynamic_slice_in_dim(q, q0, Q_BLOCK, axis=1)
        gblk = lax.dynamic_slice_in_dim(gates, q0, Q_BLOCK, axis=1)
        s_c = jnp.einsum('bqgrd,bngd->bgrqn', qblk, k_cmp).astype(jnp.float32) * scale
        s_c = s_c - slopes[None, :, :, None, None] * (tf[:, None] - cmp_mid[None, :])
        p_c = masked_softmax(s_c, cmp_end[None, :] <= t[:, None])
        o_c = jnp.einsum('bgrqn,bngd->bqgrd', p_c.astype(v_cmp.dtype), v_cmp)
        imp = selection_importance(jnp.sum(p_c, axis=2), n_slc)
        cur = t // SLC_LEN
        causal = blk_ids[None, :] <= cur[:, None]
        forced = (blk_ids[None, :] == 0) | (blk_ids[None, :] == cur[:, None]) | (blk_ids[None, :] == cur[:, None] - 1)
        score = jnp.where(forced, FORCE_SCORE, jnp.where(causal, imp, -1.0))
        _, idx = lax.top_k(score, top_n)
        kg = ks_blocks[b_ix, g_ix, idx]
        vg = vs_blocks[b_ix, g_ix, idx]
        key_pos = idx[..., None] * SLC_LEN + jnp.arange(SLC_LEN)
        mask_s = key_pos <= t[None, None, :, None, None]
        dist = tf[None, None, :, None, None] - key_pos.astype(jnp.float32)
        s_s = jnp.einsum('bqgrd,bgqnld->bgrqnl', qblk, kg).astype(jnp.float32) * scale
        s_s = s_s - slopes[None, :, :, None, None, None] * dist[:, :, None]
        p_s = masked_softmax(s_s.reshape(b, g, r, Q_BLOCK, -1), mask_s.reshape(b, g, 1, Q_BLOCK, -1))
        o_s = jnp.einsum('bgrqnl,bgqnld->bqgrd', p_s.reshape(s_s.shape).astype(vg.dtype), vg)
        kw = lax.dynamic_slice_in_dim(kw_pad, q0, Q_BLOCK + WINDOW, axis=1)
        vw = lax.dynamic_slice_in_dim(vw_pad, q0, Q_BLOCK + WINDOW, axis=1)
        s_pos = q0 - WINDOW + jnp.arange(Q_BLOCK + WINDOW)
        rel = t[:, None] - s_pos[None, :]
        mask_w = (rel >= 0) & (rel < WINDOW) & (s_pos[None, :] >= 0)
        s_w = jnp.einsum('bqgrd,bkgd->bgrqk', qblk, kw).astype(jnp.float32) * scale
        s_w = s_w - slopes[None, :, :, None, None] * rel.astype(jnp.float32)
        p_w = masked_softmax(s_w, mask_w)
        o_w = jnp.einsum('bgrqk,bkgd->bqgrd', p_w.astype(vw.dtype), vw)
        return gblk[..., 0:1] * o_c + gblk[..., 1:2] * o_s + gblk[..., 2:3] * o_w

    out = lax.map(one_block, jnp.arange(s // Q_BLOCK))
    return out.transpose(1, 0, 2, 3, 4, 5).reshape(b, s, g * r * d)


def sgu_nsa_mixer(h, w_in, w_out, sgu_w, sgu_b, sgu_g,
                  cmp_pe_k, cmp_w1_k, cmp_w2_k, cmp_pe_v, cmp_w1_v, cmp_w2_v):
    b, s, _ = h.shape
    proj = h @ w_in
    sizes = [SGU_WIDTH, SGU_WIDTH, NSA_WIDTH] + [KV_WIDTH] * 6 + [N_BRANCH * NSA_HEADS]
    splits = np.cumsum(sizes)[:-1].tolist()
    u, v, q, kc, vc, ks, vs, kw, vw, gt = jnp.split(proj, splits, axis=-1)
    u = jax.nn.gelu(u)
    v = rmsnorm(jax.nn.gelu(v).reshape(b, s, SGU_GROUPS, HEAD_DIM), sgu_g)
    w_causal = sgu_w * jnp.tril(jnp.ones((SGU_CHUNK, SGU_CHUNK), sgu_w.dtype))
    v_ch = v.reshape(b, s // SGU_CHUNK, SGU_CHUNK, SGU_GROUPS, HEAD_DIM)
    s_gate = jnp.einsum('gtp,bnpgc->bntgc', w_causal, v_ch) + sgu_b.T[None, None, :, :, None]
    y_a = u * s_gate.reshape(b, s, SGU_WIDTH)
    kv_shape = lambda z: z.reshape(b, s, NSA_KV_GROUPS, HEAD_DIM)
    k_cmp = compress_blocks(kv_shape(kc), cmp_pe_k, cmp_w1_k, cmp_w2_k)
    v_cmp = compress_blocks(kv_shape(vc), cmp_pe_v, cmp_w1_v, cmp_w2_v)
    gates = jax.nn.sigmoid(gt.reshape(b, s, NSA_KV_GROUPS, NSA_REP, N_BRANCH))
    y_b = nsa_attention(q.reshape(b, s, NSA_KV_GROUPS, NSA_REP, HEAD_DIM), k_cmp, v_cmp,
                        kv_shape(ks), kv_shape(vs), kv_shape(kw), kv_shape(vw), gates)
    return jnp.concatenate([y_a, y_b], axis=-1) @ w_out


def short_conv_mixer(h, w_in, conv_w, w_out):
    bg, cg, z = jnp.split(h @ w_in, 3, axis=-1)
    z = cg * z
    zc = lax.conv_general_dilated(z, conv_w[:, None, :], window_strides=(1,),
                                  padding=[(CONV_K - 1, 0)],
                                  dimension_numbers=('NWC', 'WIO', 'NWC'),
                                  feature_group_count=CONV_WIDTH)
    return (bg * zc) @ w_out


def setup_inputs(seed: int = 0) -> dict:
    key = jax.random.key(seed)
    ks = jax.random.split(key, 24)
    nrm = lambda k, shape, fan_in: jax.random.normal(k, shape, jnp.float32) * fan_in ** -0.5
    gain = lambda k, shape: 1.0 + 0.1 * jax.random.normal(k, shape, jnp.float32)
    return {
        'x': jax.random.normal(ks[0], (BATCH, SEQ, D_MODEL), jnp.float32),
        'norm_mix': gain(ks[1], (DEPTH, D_MODEL)),
        'norm_ffn': gain(ks[2], (DEPTH, D_MODEL)),
        'norm_f': gain(ks[3], (D_MODEL,)),
        'w_in_ab': nrm(ks[4], (N_EVEN, D_MODEL, EVEN_IN_WIDTH), D_MODEL),
        'w_out_ab': nrm(ks[5], (N_EVEN, EVEN_MIX_WIDTH, D_MODEL), EVEN_MIX_WIDTH),
        'sgu_w': nrm(ks[6], (N_EVEN, SGU_GROUPS, SGU_CHUNK, SGU_CHUNK), SGU_CHUNK),
        'sgu_b': gain(ks[7], (N_EVEN, SGU_GROUPS, SGU_CHUNK)),
        'sgu_g': gain(ks[8], (N_EVEN, SGU_GROUPS, HEAD_DIM)),
        'cmp_pe_k': 0.1 * jax.random.normal(ks[9], (N_EVEN, CMP_LEN, HEAD_DIM), jnp.float32),
        'cmp_w1_k': nrm(ks[10], (N_EVEN, CMP_LEN, HEAD_DIM, HEAD_DIM), CMP_LEN * HEAD_DIM),
        'cmp_w2_k': nrm(ks[11], (N_EVEN, HEAD_DIM, HEAD_DIM), HEAD_DIM),
        'cmp_pe_v': 0.1 * jax.random.normal(ks[12], (N_EVEN, CMP_LEN, HEAD_DIM), jnp.float32),
        'cmp_w1_v': nrm(ks[13], (N_EVEN, CMP_LEN, HEAD_DIM, HEAD_DIM), CMP_LEN * HEAD_DIM),
        'cmp_w2_v': nrm(ks[14], (N_EVEN, HEAD_DIM, HEAD_DIM), HEAD_DIM),
        'w_in_c': nrm(ks[15], (N_ODD, D_MODEL, 3 * CONV_WIDTH), D_MODEL),
        'conv_w': nrm(ks[16], (N_ODD, CONV_K, CONV_WIDTH), CONV_K),
        'w_out_c': nrm(ks[17], (N_ODD, CONV_WIDTH, D_MODEL), CONV_WIDTH),
        'w_gate': nrm(ks[18], (DEPTH, D_MODEL, D_FF), D_MODEL),
        'w_up': nrm(ks[19], (DEPTH, D_MODEL, D_FF), D_MODEL),
        'w_down': nrm(ks[20], (DEPTH, D_FF, D_MODEL), D_FF),
    }


def reference(x, norm_mix, norm_ffn, norm_f, w_in_ab, w_out_ab, sgu_w, sgu_b, sgu_g,
              cmp_pe_k, cmp_w1_k, cmp_w2_k, cmp_pe_v, cmp_w1_v, cmp_w2_v,
              w_in_c, conv_w, w_out_c, w_gate, w_up, w_down):
    h = x
    for i in range(DEPTH):
        j = i // 2
        hn = rmsnorm(h, norm_mix[i])
        if i % 2 == 0:
            mix = sgu_nsa_mixer(hn, w_in_ab[j], w_out_ab[j], sgu_w[j], sgu_b[j], sgu_g[j],
                                cmp_pe_k[j], cmp_w1_k[j], cmp_w2_k[j],
                                cmp_pe_v[j], cmp_w1_v[j], cmp_w2_v[j])
        else:
            mix = short_conv_mixer(hn, w_in_c[j], conv_w[j], w_out_c[j])
        h = h + mix
        h = h + swiglu(rmsnorm(h, norm_ffn[i]), w_gate[i], w_up[i], w_down[i])
    return rmsnorm(h, norm_f)
```

```cpp
#include <hip/hip_runtime.h>
#include <hip/hip_cooperative_groups.h>
#include <cstdio>
namespace cg = cooperative_groups;

#define DEV __device__ __forceinline__
#define LAS __attribute__((address_space(3)))
typedef unsigned short bf16_t;
typedef short bf16x8 __attribute__((ext_vector_type(8)));
typedef float f32x4 __attribute__((ext_vector_type(4)));
typedef float f32x2 __attribute__((ext_vector_type(2)));
typedef unsigned u32x4 __attribute__((ext_vector_type(4)));
typedef unsigned u32x2 __attribute__((ext_vector_type(2)));

constexpr int S_ = 16384, T_ = 32768, DM = 2048, DFF = 5632;
constexpr int LDP = 4352;
constexpr int U_OFF = 0, V_OFF = 1024, Q_OFF = 2048, KC_OFF = 3072, VC_OFF = 3328, KS_OFF = 3584, KW_OFF = 3840, GT_OFF = 4096;
constexpr int LDS_BYTES = 141312;
constexpr float EPS = 1e-6f;

struct Params { const float* in[21]; float* out; unsigned char* ws; };
constexpr size_t al256(size_t x) { return (x + 255) & ~(size_t)255; }
constexpr size_t O_WIN = 0;
constexpr size_t O_WV = O_WIN + al256((size_t)LDP * DM * 2);
constexpr size_t O_WOUT = O_WV + al256((size_t)512 * DM * 2);
constexpr size_t O_WGU0 = O_WOUT + al256((size_t)DM * DM * 2);
constexpr size_t O_WGU1 = O_WGU0 + al256((size_t)2 * DFF * DM * 2);
constexpr size_t O_WDN0 = O_WGU1 + al256((size_t)2 * DFF * DM * 2);
constexpr size_t O_WDN1 = O_WDN0 + al256((size_t)DM * DFF * 2);
constexpr size_t O_WINC = O_WDN1 + al256((size_t)DM * DFF * 2);
constexpr size_t O_WOUTC = O_WINC + al256((size_t)6144 * DM * 2);
constexpr size_t O_W1K = O_WOUTC + al256((size_t)DM * DM * 2);
constexpr size_t O_W1V = O_W1K + al256((size_t)128 * 4096 * 2);
constexpr size_t O_W2K = O_W1V + al256((size_t)128 * 4096 * 2);
constexpr size_t O_W2V = O_W2K + al256(128 * 128 * 2);
constexpr size_t O_SGUW = O_W2V + al256(128 * 128 * 2);
constexpr size_t O_CBIAS = O_SGUW + al256(8 * 128 * 128 * 2);
constexpr size_t O_KCMP = O_CBIAS + 1024;
constexpr size_t O_VCMPT = O_KCMP + al256((size_t)4 * 1024 * 128 * 2);
constexpr size_t O_HN = O_VCMPT + al256((size_t)4 * 128 * 1024 * 2);
constexpr size_t O_BIG = O_HN + al256((size_t)T_ * DM * 2);
constexpr size_t O_PROJ = O_BIG;
constexpr size_t O_VT = O_PROJ + al256((size_t)(T_ + 32) * LDP * 2);
constexpr size_t O_CAT = O_VT + al256((size_t)512 * T_ * 2);
constexpr size_t O_YPART = O_CAT + al256((size_t)T_ * DM * 2);
constexpr size_t WS_END = O_YPART + al256((size_t)T_ * 1024 * 4);
constexpr size_t O_ACT = O_BIG;
constexpr size_t O_BG = O_BIG;
constexpr size_t O_ZZ = O_BG + al256((size_t)T_ * DM * 2);
constexpr size_t O_MIX = O_ZZ + al256((size_t)T_ * DM * 2);
static_assert(O_ACT + (size_t)T_ * DFF * 2 <= WS_END && O_MIX + (size_t)T_ * DM * 2 <= WS_END, "ws alias");
#define WSB(off) ((bf16_t*)(p.ws + (off)))
#define WSF(off) ((float*)(p.ws + (off)))

DEV float bf2f(unsigned h) { return __uint_as_float(h << 16); }
DEV unsigned cvt_pk_bf16(float lo, float hi) { unsigned r; asm("v_cvt_pk_bf16_f32 %0, %1, %2" : "=v"(r) : "v"(lo), "v"(hi)); return r; }
DEV float fexp2(float x) { return __builtin_amdgcn_exp2f(x); }
DEV float frcp(float x) { return __builtin_amdgcn_rcpf(x); }
DEV float gelu_t(float x) { const float u = x * (1.0f + 0.044715f * x * x); return x * frcp(1.0f + fexp2(-2.3022082f * u)); }
DEV float silu_f(float x) { return x * frcp(1.0f + fexp2(-1.4426950409f * x)); }
DEV float sigmoid_f(float x) { return frcp(1.0f + fexp2(-1.4426950409f * x)); }
DEV f32x4 mfma16(bf16x8 a, bf16x8 b, f32x4 c) { return __builtin_amdgcn_mfma_f32_16x16x32_bf16(a, b, c, 0, 0, 0); }

namespace pg8 {
constexpr int BM = 256, BK = 64, HALF = 128, HTB = HALF * BK * 2, STAGE_BYTES = 8 * HTB, NXCD = 8, WGM = 8;
DEV int lds_byte(int r, int c) { const int st = (r >> 4) * 2 + (c >> 5), rr = r & 15, cc = c & 31, ob = rr * 64 + cc * 2; return st * 1024 + (ob ^ (((ob >> 9) & 1) << 5)); }
DEV void stage_rc(int b, int& R, int& C) { const int st = b / 1024, sb = b % 1024, swz = sb ^ (((sb >> 9) & 1) << 5); R = (st >> 1) * 16 + swz / 64; C = (st & 1) * 32 + (swz % 64) / 2; }
DEV int perm32(int rho) { const int n = rho >> 4, i = rho & 15; return 8 * (i >> 2) + 4 * n + (i & 3); }
struct Unit { int pm, pn; };
struct Gemm { const bf16_t* A; const bf16_t* Bt; int M, N, K; };
struct StaticOrder {
    int nM, nN, nwg, G, c;
    DEV void init(int M, int N, int G_, int c_) { nM = M / BM; nN = N / BM; nwg = nM * nN; G = G_; c = c_; }
    DEV bool next(int i, Unit& u) const {
        const long L = (long)i * G + c; if (L >= nwg) return false;
        int wgid = (int)L; { const int q = nwg / NXCD, r = nwg % NXCD, xcd = wgid % NXCD, off = wgid / NXCD; wgid = (xcd < r ? xcd * (q + 1) : r * (q + 1) + (xcd - r) * q) + off; }
        const int nig = WGM * nN, gid = wgid / nig, fm = gid * WGM, gsz = (nM - fm) < WGM ? (nM - fm) : WGM;
        u.pm = fm + ((wgid % nig) % gsz); u.pn = (wgid % nig) / gsz; return true;
    }
};

template <class Epi>
DEV void gemm_phase(LAS unsigned char* lds, const Gemm g, const StaticOrder& S, const Epi& E) {
    const int tid = threadIdx.x, wid = __builtin_amdgcn_readfirstlane(tid >> 6), lane = tid & 63, wr = wid >> 2, wc = wid & 3, fr = lane & 15, fq = lane >> 4;
    const int K = g.K, nt = K / BK;
    unsigned voffA[2], voffB[2];
#pragma unroll
    for (int i = 0; i < 2; ++i) { int R, C; stage_rc(tid * 16 + i * 8192, R, C); const int Rb = Epi::PERM ? ((R & ~31) + perm32(R & 31)) : R;
        voffA[i] = (unsigned)(R * K + C) * 2u; voffB[i] = (unsigned)(Rb * K + C) * 2u; }
    const size_t kstep = (size_t)(BK * 2);
    const size_t hstep = (size_t)HALF * K * 2;
    const size_t tstep = 2 * hstep;
    const unsigned ldsw = (unsigned)wid * 1024u;
    const int aoff = lds_byte(wr * 64 + fr, fq * 8), boff = lds_byte(wc * 32 + fr, fq * 8);
#define PG8_SA(b, h) (((b) * 2 + (h)) * HTB)
#define PG8_SB(b, h) ((4 + (b) * 2 + (h)) * HTB)
#define PG8_STAGE(bufoff, gbase, voff) do { _Pragma("unroll") for (int _i = 0; _i < 2; ++_i) \
        __builtin_amdgcn_global_load_lds((const unsigned*)((const char*)(gbase) + (voff)[_i]), (LAS unsigned*)(lds + (bufoff) + ldsw + _i * 8192), 16, 0, 0); } while (0)
#define PG8_LDA(dst, b, h) do { _Pragma("unroll") for (int m = 0; m < 4; ++m) _Pragma("unroll") for (int k = 0; k < 2; ++k) dst[m][k] = *(const LAS bf16x8*)(lds + PG8_SA(b, h) + aoff + m * 2048 + k * 1024); } while (0)
#define PG8_LDB(dst, b, h) do { _Pragma("unroll") for (int n = 0; n < 2; ++n) _Pragma("unroll") for (int k = 0; k < 2; ++k) dst[n][k] = *(const LAS bf16x8*)(lds + PG8_SB(b, h) + boff + n * 2048 + k * 1024); } while (0)
#define PG8_MMA(ai, bj, At, Bt) do { __builtin_amdgcn_s_setprio(1); _Pragma("unroll") for (int m = 0; m < 4; ++m) _Pragma("unroll") for (int n = 0; n < 2; ++n) _Pragma("unroll") for (int k = 0; k < 2; ++k) \
        acc[ai][bj][m][n] = __builtin_amdgcn_mfma_f32_16x16x32_bf16(Bt[n][k], At[m][k], acc[ai][bj][m][n], 0, 0, 0); __builtin_amdgcn_s_setprio(0); } while (0)
#define PG8_WAIT_V(n) asm volatile("s_waitcnt vmcnt(" #n ")" ::: "memory")
#define PG8_WAIT_L(n) asm volatile("s_waitcnt lgkmcnt(" #n ")" ::: "memory")
#define PG8_BAR __builtin_amdgcn_s_barrier()
#define PG8_SCHED __builtin_amdgcn_sched_barrier(0)
    Unit cur, nxt; int ui = 0;
    if (!S.next(0, cur)) return;
    f32x4 acc[2][2][4][2];
#pragma unroll
    for (int a = 0; a < 2; ++a)
#pragma unroll
        for (int b = 0; b < 2; ++b)
#pragma unroll
            for (int m = 0; m < 4; ++m)
#pragma unroll
                for (int n = 0; n < 2; ++n) acc[a][b][m][n] = (f32x4){0.f, 0.f, 0.f, 0.f};
    bf16x8 At[4][2], B0[2][2], B1[2][2];
    const char* cA = (const char*)g.A + (size_t)cur.pm * tstep; const char* cB = (const char*)g.Bt + (size_t)cur.pn * tstep;
    PG8_STAGE(PG8_SB(0, 0), cB, voffB); PG8_STAGE(PG8_SA(0, 0), cA, voffA); PG8_STAGE(PG8_SB(0, 1), cB + hstep, voffB); PG8_STAGE(PG8_SA(0, 1), cA + hstep, voffA);
    if (wr == 1) PG8_BAR;
    PG8_WAIT_V(4); PG8_BAR;
    PG8_STAGE(PG8_SB(1, 0), cB + kstep, voffB); PG8_STAGE(PG8_SA(1, 0), cA + kstep, voffA); PG8_STAGE(PG8_SB(1, 1), cB + hstep + kstep, voffB);
    PG8_WAIT_V(6); PG8_BAR;
    for (;;) {
        const bool has_next = S.next(ui + 1, nxt);
        const char* nA = has_next ? (const char*)g.A + (size_t)nxt.pm * tstep : cA; const char* nB = has_next ? (const char*)g.Bt + (size_t)nxt.pn * tstep : cB;
        for (int t = 0; t < nt; t += 2) {
            const bool last = (t == nt - 2);
            const char* a1 = cA + (size_t)(t + 1) * kstep;
            const char* a2 = last ? nA : cA + (size_t)(t + 2) * kstep; const char* b2 = last ? nB : cB + (size_t)(t + 2) * kstep;
            const char* a3 = a2 + kstep; const char* b3 = b2 + kstep;
            PG8_LDB(B0, 0, 0); PG8_SCHED; PG8_LDA(At, 0, 0); PG8_STAGE(PG8_SA(1, 1), a1 + hstep, voffA);
            PG8_WAIT_L(8); PG8_BAR; PG8_WAIT_L(0); PG8_MMA(0, 0, At, B0); PG8_BAR; PG8_SCHED;
            PG8_LDB(B1, 0, 1); PG8_STAGE(PG8_SB(0, 0), b2, voffB);
            PG8_BAR; PG8_WAIT_L(0); PG8_MMA(0, 1, At, B1); PG8_BAR;
            PG8_LDA(At, 0, 1); PG8_STAGE(PG8_SA(0, 0), a2, voffA);
            PG8_BAR; PG8_WAIT_L(0); PG8_MMA(1, 0, At, B0); PG8_BAR; PG8_SCHED;
            PG8_STAGE(PG8_SB(0, 1), b2 + hstep, voffB);
            PG8_WAIT_V(6); PG8_BAR; PG8_MMA(1, 1, At, B1); PG8_BAR;
            PG8_LDB(B0, 1, 0); PG8_SCHED; PG8_LDA(At, 1, 0); PG8_STAGE(PG8_SA(0, 1), a2 + hstep, voffA);
            PG8_WAIT_L(8); PG8_BAR; PG8_WAIT_L(0); PG8_MMA(0, 0, At, B0); PG8_BAR; PG8_SCHED;
            PG8_LDB(B1, 1, 1); PG8_STAGE(PG8_SB(1, 0), b3, voffB);
            PG8_BAR; PG8_WAIT_L(0); PG8_MMA(0, 1, At, B1); PG8_BAR;
            PG8_LDA(At, 1, 1); PG8_STAGE(PG8_SA(1, 0), a3, voffA);
            PG8_BAR; PG8_WAIT_L(0); PG8_MMA(1, 0, At, B0); PG8_BAR; PG8_SCHED;
            PG8_STAGE(PG8_SB(1, 1), b3 + hstep, voffB);
            PG8_WAIT_V(6); PG8_BAR; PG8_MMA(1, 1, At, B1); PG8_BAR;
        }
        E(acc, cur, wr, wc, fr, fq);
        if (!has_next) break;
#pragma unroll
        for (int a = 0; a < 2; ++a)
#pragma unroll
            for (int b = 0; b < 2; ++b)
#pragma unroll
                for (int m = 0; m < 4; ++m)
#pragma unroll
                    for (int n = 0; n < 2; ++n) acc[a][b][m][n] = (f32x4){0.f, 0.f, 0.f, 0.f};
        cur = nxt; cA = nA; cB = nB; ++ui;
    }
    PG8_WAIT_V(0);
    if (wr == 0) PG8_BAR;
    PG8_BAR;
#undef PG8_SA
#undef PG8_SB
#undef PG8_STAGE
#undef PG8_LDA
#undef PG8_LDB
#undef PG8_MMA
#undef PG8_WAIT_V
#undef PG8_WAIT_L
#undef PG8_BAR
#undef PG8_SCHED
}

struct EpiBf16Act {
    static constexpr bool PERM = true;
    bf16_t* O; int ldc; int gelu_tiles;
    DEV void operator()(const f32x4 (&acc)[2][2][4][2], const Unit& u, int wr, int wc, int fr, int fq) const {
        const int row0 = u.pm * BM + wr * 64 + fr, col0 = u.pn * BM + wc * 32 + 8 * fq;
        const bool act = u.pn < gelu_tiles;
#pragma unroll
        for (int ai = 0; ai < 2; ++ai)
#pragma unroll
            for (int m = 0; m < 4; ++m) { bf16_t* rowp = O + (size_t)(row0 + ai * HALF + m * 16) * ldc + col0;
#pragma unroll
                for (int bj = 0; bj < 2; ++bj) { f32x4 v0 = acc[ai][bj][m][0], v1 = acc[ai][bj][m][1];
                    if (act) {
#pragma unroll
                        for (int j = 0; j < 4; ++j) { v0[j] = gelu_t(v0[j]); v1[j] = gelu_t(v1[j]); } }
                    u32x4 w; w.x = cvt_pk_bf16(v0[0], v0[1]); w.y = cvt_pk_bf16(v0[2], v0[3]); w.z = cvt_pk_bf16(v1[0], v1[1]); w.w = cvt_pk_bf16(v1[2], v1[3]);
                    *(u32x4*)(rowp + bj * HALF) = w; } }
    }
};
struct EpiPair {
    static constexpr bool PERM = true;
    bf16_t* O; int ldc; int mode; bf16_t* O0; int ldc0; int plain_tiles;
    DEV void operator()(const f32x4 (&acc)[2][2][4][2], const Unit& u, int wr, int wc, int fr, int fq) const {
        const int row0 = u.pm * BM + wr * 64 + fr;
        if (mode == 1 && u.pn < plain_tiles) {
            const int col0 = u.pn * BM + wc * 32 + 8 * fq;
#pragma unroll
            for (int ai = 0; ai < 2; ++ai)
#pragma unroll
                for (int m = 0; m < 4; ++m) { bf16_t* rowp = O0 + (size_t)(row0 + ai * HALF + m * 16) * ldc0 + col0;
#pragma unroll
                    for (int bj = 0; bj < 2; ++bj) { const f32x4 v0 = acc[ai][bj][m][0], v1 = acc[ai][bj][m][1];
                        u32x4 w; w.x = cvt_pk_bf16(v0[0], v0[1]); w.y = cvt_pk_bf16(v0[2], v0[3]); w.z = cvt_pk_bf16(v1[0], v1[1]); w.w = cvt_pk_bf16(v1[2], v1[3]);
                        *(u32x4*)(rowp + bj * HALF) = w; } }
            return;
        }
        const int pt = (mode == 1) ? (u.pn - plain_tiles) : u.pn;
        const int col0 = pt * HALF + wc * 32 + 8 * fq;
#pragma unroll
        for (int ai = 0; ai < 2; ++ai)
#pragma unroll
            for (int m = 0; m < 4; ++m) { bf16_t* rowp = O + (size_t)(row0 + ai * HALF + m * 16) * ldc + col0;
                f32x4 r0, r1;
#pragma unroll
                for (int j = 0; j < 4; ++j) {
                    const float a0 = acc[ai][0][m][0][j], a1 = acc[ai][0][m][1][j], b0 = acc[ai][1][m][0][j], b1 = acc[ai][1][m][1][j];
                    r0[j] = (mode == 0 ? silu_f(a0) : a0) * b0; r1[j] = (mode == 0 ? silu_f(a1) : a1) * b1; }
                u32x4 w; w.x = cvt_pk_bf16(r0[0], r0[1]); w.y = cvt_pk_bf16(r0[2], r0[3]); w.z = cvt_pk_bf16(r1[0], r1[1]); w.w = cvt_pk_bf16(r1[2], r1[3]);
                *(u32x4*)rowp = w; }
    }
};
struct EpiResid {
    static constexpr bool PERM = false;
    float* C; const float* R; int ldc;
    DEV void operator()(const f32x4 (&acc)[2][2][4][2], const Unit& u, int wr, int wc, int fr, int fq) const {
        const int row0 = u.pm * BM + wr * 64 + fr, col0 = u.pn * BM + wc * 32 + 4 * fq;
#pragma unroll
        for (int ai = 0; ai < 2; ++ai)
#pragma unroll
            for (int m = 0; m < 4; ++m) { const size_t ro = (size_t)(row0 + ai * HALF + m * 16) * ldc + col0;
#pragma unroll
                for (int bj = 0; bj < 2; ++bj)
#pragma unroll
                    for (int n = 0; n < 2; ++n) { const f32x4 r = *(const f32x4*)(R + ro + bj * HALF + n * 16); *(f32x4*)(C + ro + bj * HALF + n * 16) = acc[ai][bj][m][n] + r; } }
    }
};
}

template <class Epi>
DEV void run_gemm(unsigned char* shm, const bf16_t* A, const bf16_t* Bt, int M, int N, int K, const Epi& E) {
    pg8::Gemm g; g.A = A; g.Bt = Bt; g.M = M; g.N = N; g.K = K;
    pg8::StaticOrder S; S.init(M, N, (int)gridDim.x, (int)blockIdx.x);
    pg8::gemm_phase<Epi>((LAS unsigned char*)shm, g, S, E);
    __syncthreads();
}

template <class CM>
DEV void transpose_conv(unsigned char* shm, bf16_t* __restrict__ dst, int Nd, int K, int ld, const float* rowscale, const CM cm) {
    float* lt = (float*)shm;
    const int tid = threadIdx.x, tn = Nd >> 6, tk = K >> 6, ntile = tn * tk;
    for (int tile = blockIdx.x; tile < ntile; tile += gridDim.x) {
        const int n0 = (tile % tn) << 6, k0 = (tile / tn) << 6;
        const int nn = tid & 63, kq = tid >> 6;
        const float* cp = cm(n0 + nn);
#pragma unroll
        for (int i = 0; i < 8; ++i) { const int kk = kq + 8 * i; float v = cp ? cp[(size_t)(k0 + kk) * ld] : 0.f; if (rowscale) v *= rowscale[k0 + kk]; lt[kk * 65 + nn] = v; }
        __syncthreads();
#pragma unroll
        for (int i = 0; i < 4; ++i) { const int pi = tid + 512 * i, n2 = pi >> 5, k2 = (pi & 31) * 2;
            *(unsigned*)(dst + (size_t)(n0 + n2) * K + k0 + k2) = cvt_pk_bf16(lt[k2 * 65 + n2], lt[(k2 + 1) * 65 + n2]); }
        __syncthreads();
    }
}
struct CmPlain { const float* src; DEV const float* operator()(int n) const { return src + n; } };
struct CmWin { const float* src;
    DEV const float* operator()(int n) const { if (n < 3840) return src + n; if (n < 4096) return src + n + 256; if (n < 4120) return src + n + 512; return nullptr; } };
struct CmWv { const float* src; DEV const float* operator()(int n) const { return n < 256 ? src + 3840 + n : src + 4352 + (n - 256); } };
struct CmGU { const float* gate; const float* up; DEV const float* operator()(int n) const { const int pn = n >> 8, bj = (n >> 7) & 1, i = n & 127; const long long diff = (const char*)up - (const char*)gate; return (const float*)((const char*)gate + (long long)bj * diff) + pn * 128 + i; } };
struct CmInC { const float* src; DEV const float* operator()(int n) const { if (n < 2048) return src + n; const int m = n - 2048, pn = m >> 8, bj = (m >> 7) & 1, i = m & 127; return src + 2048 + bj * 2048 + pn * 128 + i; } };

DEV void rmsnorm_rows(const float* src, const float* gain, bf16_t* dst, float* dstf) {
    const int lane = threadIdx.x & 63, wv = threadIdx.x >> 6;
    f32x4 gv[8];
#pragma unroll
    for (int i = 0; i < 8; ++i) gv[i] = *(const f32x4*)(gain + (i * 64 + lane) * 4);
    for (int row = blockIdx.x * 8 + wv; row < T_; row += gridDim.x * 8) {
        const float* rp = src + (size_t)row * DM;
        f32x4 v[8]; float ss = 0.f;
#pragma unroll
        for (int i = 0; i < 8; ++i) { v[i] = *(const f32x4*)(rp + (i * 64 + lane) * 4); ss += v[i][0] * v[i][0] + v[i][1] * v[i][1] + v[i][2] * v[i][2] + v[i][3] * v[i][3]; }
#pragma unroll
        for (int o = 32; o >= 1; o >>= 1) ss += __shfl_xor(ss, o);
        const float rs = rsqrtf(ss * (1.0f / DM) + EPS);
#pragma unroll
        for (int i = 0; i < 8; ++i) { const f32x4 y = v[i] * rs * gv[i];
            if (dst) { u32x2 w; w.x = cvt_pk_bf16(y[0], y[1]); w.y = cvt_pk_bf16(y[2], y[3]); *(u32x2*)(dst + (size_t)row * DM + (i * 64 + lane) * 4) = w; }
            else *(f32x4*)(dstf + (size_t)row * DM + (i * 64 + lane) * 4) = y; }
    }
}

DEV void phase_prep(const Params& p, unsigned char* shm) {
    const int tid = threadIdx.x;
    transpose_conv(shm, WSB(O_WIN), 4352, 2048, 4632, nullptr, CmWin{p.in[4]});
    transpose_conv(shm, WSB(O_WV), 512, 2048, 4632, nullptr, CmWv{p.in[4]});
    transpose_conv(shm, WSB(O_WOUT), 2048, 2048, 2048, nullptr, CmPlain{p.in[5]});
    transpose_conv(shm, WSB(O_WGU0), 2 * DFF, 2048, DFF, nullptr, CmGU{p.in[18], p.in[19]});
    transpose_conv(shm, WSB(O_WGU1), 2 * DFF, 2048, DFF, nullptr, CmGU{p.in[18] + (size_t)DM * DFF, p.in[19] + (size_t)DM * DFF});
    transpose_conv(shm, WSB(O_WDN0), 2048, DFF, 2048, nullptr, CmPlain{p.in[20]});
    transpose_conv(shm, WSB(O_WDN1), 2048, DFF, 2048, nullptr, CmPlain{p.in[20] + (size_t)DFF * DM});
    transpose_conv(shm, WSB(O_WINC), 6144, 2048, 6144, nullptr, CmInC{p.in[15]});
    transpose_conv(shm, WSB(O_WOUTC), 2048, 2048, 2048, nullptr, CmPlain{p.in[17]});
    transpose_conv(shm, WSB(O_W1K), 128, 4096, 128, nullptr, CmPlain{p.in[10]});
    transpose_conv(shm, WSB(O_W1V), 128, 4096, 128, nullptr, CmPlain{p.in[13]});
    transpose_conv(shm, WSB(O_W2K), 128, 128, 128, nullptr, CmPlain{p.in[11]});
    transpose_conv(shm, WSB(O_W2V), 128, 128, 128, nullptr, CmPlain{p.in[14]});
    for (int i = blockIdx.x * 512 + tid; i < 8 * 128 * 128; i += gridDim.x * 512) { const int pp = i & 127, t = (i >> 7) & 127; WSB(O_SGUW)[i] = (bf16_t)(cvt_pk_bf16(pp <= t ? p.in[6][i] : 0.f, 0.f) & 0xffffu); }
    if (blockIdx.x < 2) {
        float* red = (float*)shm;
        const float* pe = blockIdx.x ? p.in[12] : p.in[9]; const float* w1 = blockIdx.x ? p.in[13] : p.in[10];
        const int e = tid & 127, part = tid >> 7; float s = 0.f;
        for (int k = part * 1024; k < part * 1024 + 1024; ++k) s += pe[k] * w1[(size_t)k * 128 + e];
        red[part * 128 + e] = s; __syncthreads();
        if (tid < 128) WSF(O_CBIAS)[blockIdx.x * 128 + tid] = red[tid] + red[128 + tid] + red[256 + tid] + red[384 + tid];
        __syncthreads();
    }
    rmsnorm_rows(p.in[0], p.in[1], WSB(O_HN), nullptr);
}

DEV void sgu_item(const Params& p, unsigned char* shm, int item) {
    const int tid = threadIdx.x, w = tid >> 6, lane = tid & 63, fr = lane & 15, fq = lane >> 4;
    const int g = item & 7, n = (item >> 3) & 127, b = item >> 10;
    const int tok0 = b * S_ + n * 128;
    bf16_t* vT = (bf16_t*)shm;
#pragma unroll
    for (int i = 0; i < 4; ++i) {
        const int idx = tid + 512 * i, prow = idx >> 4, ch = idx & 15;
        const u32x4 raw = *(const u32x4*)(WSB(O_PROJ) + (size_t)(tok0 + prow) * LDP + V_OFF + g * 128 + ch * 8);
        float f[8];
#pragma unroll
        for (int e = 0; e < 4; ++e) { f[2 * e] = bf2f(raw[e] & 0xffffu); f[2 * e + 1] = bf2f(raw[e] >> 16); }
        float ss = 0.f;
#pragma unroll
        for (int e = 0; e < 8; ++e) ss += f[e] * f[e];
        ss += __shfl_xor(ss, 1); ss += __shfl_xor(ss, 2); ss += __shfl_xor(ss, 4); ss += __shfl_xor(ss, 8);
        const float rs = rsqrtf(ss * (1.0f / 128.0f) + EPS);
        const f32x4 g0 = *(const f32x4*)(p.in[8] + g * 128 + ch * 8), g1 = *(const f32x4*)(p.in[8] + g * 128 + ch * 8 + 4);
#pragma unroll
        for (int e = 0; e < 8; ++e) { const float gg = e < 4 ? g0[e & 3] : g1[e & 3]; vT[(ch * 8 + e) * 136 + prow] = (bf16_t)(cvt_pk_bf16(f[e] * rs * gg, 0.f) & 0xffffu); }
    }
    __syncthreads();
    f32x4 acc[8];
#pragma unroll
    for (int ct = 0; ct < 8; ++ct) acc[ct] = (f32x4){0.f, 0.f, 0.f, 0.f};
    const bf16_t* Wg = WSB(O_SGUW) + (size_t)(g * 128 + 16 * w + fr) * 128;
    const int nks = (w >> 1) + 1;
    for (int ks = 0; ks < nks; ++ks) {
        const bf16x8 wf = *(const bf16x8*)(Wg + 32 * ks + 8 * fq);
#pragma unroll
        for (int ct = 0; ct < 8; ++ct) { const bf16x8 vf = *(const bf16x8*)(vT + (16 * ct + fr) * 136 + 32 * ks + 8 * fq); acc[ct] = mfma16(vf, wf, acc[ct]); }
    }
    const int t = 16 * w + fr; const float bias = p.in[7][g * 128 + t]; const size_t tok = (size_t)(tok0 + t);
#pragma unroll
    for (int ct = 0; ct < 8; ++ct) {
        const u32x2 uu = *(const u32x2*)(WSB(O_PROJ) + tok * LDP + U_OFF + g * 128 + 16 * ct + 4 * fq);
        const float y0 = bf2f(uu.x & 0xffffu) * (acc[ct][0] + bias), y1 = bf2f(uu.x >> 16) * (acc[ct][1] + bias), y2 = bf2f(uu.y & 0xffffu) * (acc[ct][2] + bias), y3 = bf2f(uu.y >> 16) * (acc[ct][3] + bias);
        u32x2 o; o.x = cvt_pk_bf16(y0, y1); o.y = cvt_pk_bf16(y2, y3);
        *(u32x2*)(WSB(O_CAT) + tok * 2048 + g * 128 + 16 * ct + 4 * fq) = o;
    }
    __syncthreads();
}

DEV void compress_item(const Params& p, unsigned char* shm, int item) {
    const int tid = threadIdx.x, w = tid >> 6, lane = tid & 63, fr = lane & 15, fq = lane >> 4;
    const int kv = item >> 7, b = (item >> 6) & 1, g = (item >> 5) & 1, n0 = (item & 31) * 32;
    float* part = (float*)shm;
    bf16_t* hid = (bf16_t*)(shm + 131072);
    const bf16_t* W1 = kv ? WSB(O_W1V) : WSB(O_W1K);
    const bf16_t* W2 = kv ? WSB(O_W2V) : WSB(O_W2K);
    const int coff = (kv ? VC_OFF : KC_OFF) + g * 128;
    {
        f32x4 acc[2][8];
#pragma unroll
        for (int ns = 0; ns < 2; ++ns)
#pragma unroll
            for (int et = 0; et < 8; ++et) acc[ns][et] = (f32x4){0.f, 0.f, 0.f, 0.f};
        for (int ks = 0; ks < 16; ++ks) {
            const int l = 4 * w + (ks >> 2), d0 = 32 * (ks & 3) + 8 * fq;
            bf16x8 af[2];
#pragma unroll
            for (int ns = 0; ns < 2; ++ns) { const int nn = n0 + 16 * ns + fr; af[ns] = *(const bf16x8*)(WSB(O_PROJ) + (size_t)(b * S_ + 16 * nn + l) * LDP + coff + d0); }
#pragma unroll
            for (int et = 0; et < 8; ++et) { const bf16x8 wf = *(const bf16x8*)(W1 + (size_t)(16 * et + fr) * 4096 + 512 * w + 32 * ks + 8 * fq);
                acc[0][et] = mfma16(wf, af[0], acc[0][et]); acc[1][et] = mfma16(wf, af[1], acc[1][et]); }
        }
#pragma unroll
        for (int ns = 0; ns < 2; ++ns)
#pragma unroll
            for (int et = 0; et < 8; ++et) *(f32x4*)(part + (size_t)w * 4096 + (16 * ns + fr) * 128 + 16 * et + 4 * fq) = acc[ns][et];
    }
    __syncthreads();
#pragma unroll
    for (int i = 0; i < 8; ++i) { const int idx = tid + 512 * i, nn = idx >> 7, e = idx & 127; float s = WSF(O_CBIAS)[kv * 128 + e];
#pragma unroll
        for (int ww = 0; ww < 8; ++ww) s += part[ww * 4096 + idx];
        hid[nn * 136 + e] = (bf16_t)(cvt_pk_bf16(gelu_t(s), 0.f) & 0xffffu); }
    __syncthreads();
    {
        f32x4 acc[2];
        acc[0] = acc[1] = (f32x4){0.f, 0.f, 0.f, 0.f};
#pragma unroll
        for (int ks = 0; ks < 4; ++ks) {
            const bf16x8 wf = *(const bf16x8*)(W2 + (size_t)(16 * w + fr) * 128 + 32 * ks + 8 * fq);
#pragma unroll
            for (int ns = 0; ns < 2; ++ns) { const bf16x8 hf = *(const bf16x8*)(hid + (16 * ns + fr) * 136 + 32 * ks + 8 * fq);
                acc[ns] = kv ? mfma16(hf, wf, acc[ns]) : mfma16(wf, hf, acc[ns]); }
        }
        const int bg = b * 2 + g;
#pragma unroll
        for (int ns = 0; ns < 2; ++ns) {
            if (kv == 0) {
                const int nn = n0 + 16 * ns + fr; f32x4 v = acc[ns]; if (nn >= 1023) v = (f32x4){0.f, 0.f, 0.f, 0.f};
                u32x2 o; o.x = cvt_pk_bf16(v[0], v[1]); o.y = cvt_pk_bf16(v[2], v[3]);
                *(u32x2*)(WSB(O_KCMP) + ((size_t)bg * 1024 + nn) * 128 + 16 * w + 4 * fq) = o;
            } else {
                const int nb = n0 + 16 * ns + 4 * fq; f32x4 v = acc[ns]; if (nb + 3 >= 1023) v[3] = 0.f;
                u32x2 o; o.x = cvt_pk_bf16(v[0], v[1]); o.y = cvt_pk_bf16(v[2], v[3]);
                *(u32x2*)(WSB(O_VCMPT) + ((size_t)bg * 128 + 16 * w + fr) * 1024 + nb) = o;
            }
        }
    }
    __syncthreads();
}

constexpr int KB_BYTES = 16384, VB_BYTES = 16384;
constexpr int NQS = 1, QW = 16 * NQS, QI = 2 * QW;
constexpr int A_IMP = 0, IMP_STR = 260, A_MASK = A_IMP + QI * IMP_STR * 4, A_UNI = A_MASK + QI * 8 * 4;
constexpr int A_KB0 = (A_UNI + 32 + 4095) & ~4095, A_VB0 = A_KB0 + 16384, A_KB1 = A_KB0 + 32768, A_VB1 = A_KB0 + 49152;
static_assert(A_UNI + 32 <= 65536 && A_VB1 + 16384 <= LDS_BYTES, "lds");

DEV void tile_dma(unsigned char* shm, int kboff, int vboff, const char* kp, size_t kstr, const char* vp, size_t vstr, bool withV) {
    const int tid = threadIdx.x, wid = __builtin_amdgcn_readfirstlane(tid >> 6);
    LAS unsigned char* lds = (LAS unsigned char*)shm;
#pragma unroll
    for (int i = 0; i < 2; ++i) { const int P = tid * 16 + i * 8192, row = P >> 8, c = ((P >> 4) & 15) ^ (row & 15);
        __builtin_amdgcn_global_load_lds((const unsigned*)(kp + (size_t)row * kstr + c * 16), (LAS unsigned*)(lds + kboff + wid * 1024 + i * 8192), 16, 0, 0); }
    if (withV) {
#pragma unroll
        for (int i = 0; i < 2; ++i) { const int P = tid * 16 + i * 8192, row = P >> 7, c = ((P >> 4) & 7) ^ ((row >> 1) & 7);
            __builtin_amdgcn_global_load_lds((const unsigned*)(vp + (size_t)row * vstr + c * 16), (LAS unsigned*)(lds + vboff + wid * 1024 + i * 8192), 16, 0, 0); }
    }
}
DEV int next_bit(const unsigned* uni, int from) {
    for (int w = from >> 5; w < 8; ++w) { unsigned xw = uni[w]; if (w == (from >> 5)) xw &= (~0u) << (from & 31); if (xw) return w * 32 + __builtin_ctz(xw); }
    return -1;
}

struct AttnState { f32x4 O[NQS][8]; float m[NQS], l[NQS], invl[NQS]; };

template <int BR>
DEV void attn_tile(const unsigned char* kb, const unsigned char* vb, const bf16x8 (&qf)[NQS][4], AttnState& st, int tilebase,
                   const int (&tq)[NQS], const float (&ctq)[NQS], float slope2, const bool (&qsel)[NQS], unsigned* imp, int qrow, int fr, int fq) {
    f32x4 s[NQS][4];
#pragma unroll
    for (int kt = 0; kt < 4; ++kt) {
#pragma unroll
        for (int qs = 0; qs < NQS; ++qs) s[qs][kt] = (f32x4){0.f, 0.f, 0.f, 0.f};
#pragma unroll
        for (int ks = 0; ks < 4; ++ks) {
            const bf16x8 kf = *(const bf16x8*)(kb + (16 * kt + fr) * 256 + (((4 * ks + fq) ^ fr) << 4));
#pragma unroll
            for (int qs = 0; qs < NQS; ++qs) s[qs][kt] = mfma16(kf, qf[qs][ks], s[qs][kt]);
        }
    }
    constexpr float SC = 0.08838834764831845f * 1.4426950408889634f;
#pragma unroll
    for (int qs = 0; qs < NQS; ++qs) {
        float tmax = -1e30f;
#pragma unroll
        for (int kt = 0; kt < 4; ++kt)
#pragma unroll
            for (int j = 0; j < 4; ++j) {
                const int idx = tilebase + 16 * kt + 4 * fq + j;
                const int kend = (BR == 1 || BR == 2) ? 16 * idx + 31 : idx;
                const float kpf = (BR == 1 || BR == 2) ? (16.0f * (float)idx + 15.5f) : (float)idx;
                bool valid = kend <= tq[qs];
                if (BR == 0) valid = valid && (idx > tq[qs] - 512);
                if (BR == 3) valid = valid && qsel[qs];
                float xv = fmaf(s[qs][kt][j], SC, fmaf(slope2, kpf, ctq[qs]));
                xv = valid ? xv : -1e30f;
                s[qs][kt][j] = xv; tmax = fmaxf(tmax, xv);
            }
        if (BR == 2) {
#pragma unroll
            for (int kt = 0; kt < 4; ++kt)
#pragma unroll
                for (int j = 0; j < 4; ++j) s[qs][kt][j] = fexp2(s[qs][kt][j] - st.m[qs]) * st.invl[qs];
        } else {
            tmax = fmaxf(tmax, __shfl_xor(tmax, 16)); tmax = fmaxf(tmax, __shfl_xor(tmax, 32));
            const float mnew = fmaxf(st.m[qs], tmax);
            const float alpha = fexp2(st.m[qs] - mnew);
            st.m[qs] = mnew;
            float ls = 0.f;
#pragma unroll
            for (int kt = 0; kt < 4; ++kt)
#pragma unroll
                for (int j = 0; j < 4; ++j) { const float xv = s[qs][kt][j]; const float pv = xv > -1e29f ? fexp2(xv - mnew) : 0.f; s[qs][kt][j] = pv; ls += pv; }
            st.l[qs] = st.l[qs] * alpha + ls;
            if (BR != 1) {
#pragma unroll
                for (int dt = 0; dt < 8; ++dt) st.O[qs][dt] *= alpha;
            }
        }
#ifndef PROBE_NO_IMP
        if (BR == 2) {
            unsigned* ip = imp + (qrow + 16 * qs) * IMP_STR + (tilebase >> 2) + fq;
#pragma unroll
            for (int kt = 0; kt < 4; ++kt) {
                const float p0 = s[qs][kt][0], p1 = s[qs][kt][1], p2 = s[qs][kt][2], p3 = s[qs][kt][3];
                const unsigned ua = (unsigned)(fmaf(2.0f, p0 + p1 + p2, p3) * 268435456.0f + 0.5f), uc = (unsigned)(p3 * 268435456.0f + 0.5f);
                const int J = (tilebase >> 2) + 4 * kt + fq;
                atomicAdd(ip + 4 * kt, ua);
                atomicAdd(ip + 4 * kt + (J + 1 < 256 ? 1 : 0), J + 1 < 256 ? uc : 0u);
            }
        }
#endif
    }
    if (BR == 1) return;
#pragma unroll
    for (int s2 = 0; s2 < 2; ++s2) {
        bf16x8 pf[NQS];
#pragma unroll
        for (int qs = 0; qs < NQS; ++qs) {
            u32x4 pk; pk.x = cvt_pk_bf16(s[qs][2 * s2][0], s[qs][2 * s2][1]); pk.y = cvt_pk_bf16(s[qs][2 * s2][2], s[qs][2 * s2][3]);
            pk.z = cvt_pk_bf16(s[qs][2 * s2 + 1][0], s[qs][2 * s2 + 1][1]); pk.w = cvt_pk_bf16(s[qs][2 * s2 + 1][2], s[qs][2 * s2 + 1][3]);
            pf[qs] = __builtin_bit_cast(bf16x8, pk);
        }
#pragma unroll
        for (int dt = 0; dt < 8; ++dt) {
            const unsigned char* vrow = vb + (16 * dt + fr) * 128 + (fq & 1) * 8;
            const int c0 = 4 * s2 + (fq >> 1), sw = (fr >> 1) & 7;
            const u32x2 lo = *(const u32x2*)(vrow + ((c0 ^ sw) << 4)), hi = *(const u32x2*)(vrow + (((c0 + 2) ^ sw) << 4));
            u32x4 vv; vv.x = lo.x; vv.y = lo.y; vv.z = hi.x; vv.w = hi.y;
            const bf16x8 vf = __builtin_bit_cast(bf16x8, vv);

#pragma unroll
            for (int qs = 0; qs < NQS; ++qs) st.O[qs][dt] = mfma16(vf, pf[qs], st.O[qs][dt]);
        }
    }
}

struct AttnItem { int b, g, t0; };

template <int BR>
DEV void attn_branch(const Params& p, unsigned char* shm, const AttnItem it, const bf16x8 (&qf)[NQS][4], AttnState& st,
                     const int (&tq)[NQS], const float (&ctq)[NQS], float slope2, int first_or_cnt) {
    const int tid = threadIdx.x, lane = tid & 63, fr = lane & 15, fq = lane >> 4, w = tid >> 6, wq = w & 1;
    const unsigned* uni = (const unsigned*)(shm + A_UNI);
    const unsigned* mask = (const unsigned*)(shm + A_MASK);
    unsigned* imp = (unsigned*)(shm + A_IMP);
    const bool withV = (BR != 1);
    const int bg = it.b * 2 + it.g;
    const int qrow = wq * QW + fr;
    int cur;
    if (BR == 0) cur = first_or_cnt; else if (BR == 3) cur = next_bit(uni, 0); else cur = 0;
    auto nexttile = [&](int c) -> int {
        if (BR == 0) return c + 1 <= 8 ? c + 1 : -1;
        if (BR == 3) return next_bit(uni, c + 1);
        return c + 1 < first_or_cnt ? c + 1 : -1;
    };
    auto tbase = [&](int c) -> int { return BR == 0 ? (it.t0 & ~63) - 512 + 64 * c : 64 * c; };
    auto kptr = [&](int c) -> const char* {
        if (BR == 0) return (const char*)(WSB(O_PROJ) + (size_t)(it.b * S_ + tbase(c)) * LDP + KW_OFF + it.g * 128);
        if (BR == 3) return (const char*)(WSB(O_PROJ) + (size_t)(it.b * S_ + tbase(c)) * LDP + KS_OFF + it.g * 128);
        return (const char*)(WSB(O_KCMP) + ((size_t)bg * 1024 + tbase(c)) * 128);
    };
    auto vptr = [&](int c) -> const char* {
        if (BR == 0) return (const char*)(WSB(O_VT) + (size_t)(256 + it.g * 128) * T_ + it.b * S_ + tbase(c));
        if (BR == 3) return (const char*)(WSB(O_VT) + (size_t)(it.g * 128) * T_ + it.b * S_ + tbase(c));
        return (const char*)(WSB(O_VCMPT) + (size_t)bg * 128 * 1024 + tbase(c));
    };
    const size_t kstr = (BR == 0 || BR == 3) ? (size_t)LDP * 2 : 256, vstr = (BR == 0 || BR == 3) ? (size_t)T_ * 2 : 2048;
    if (cur < 0) return;
    tile_dma(shm, A_KB0, A_VB0, kptr(cur), kstr, vptr(cur), vstr, withV);
    asm volatile("s_waitcnt vmcnt(0)" ::: "memory");
    __syncthreads();
    int buf = 0;
    while (cur >= 0) {
        const int nxt = nexttile(cur);
        if (nxt >= 0) tile_dma(shm, buf ? A_KB0 : A_KB1, buf ? A_VB0 : A_VB1, kptr(nxt), kstr, vptr(nxt), vstr, withV);
        bool qsel[NQS]; bool anysel = false;
#pragma unroll
        for (int qs = 0; qs < NQS; ++qs) qsel[qs] = true;
        bool run = true;
        if (BR == 3) {
#pragma unroll
            for (int qs = 0; qs < NQS; ++qs) { qsel[qs] = (mask[(qrow + 16 * qs) * 8 + (cur >> 5)] >> (cur & 31)) & 1u; anysel = anysel | qsel[qs]; }
            run = __any((int)anysel) != 0;
        }
        if (run) attn_tile<BR>(shm + (buf ? A_KB1 : A_KB0), shm + (buf ? A_VB1 : A_VB0), qf, st, tbase(cur), tq, ctq, slope2, qsel, imp, qrow, fr, fq);
        asm volatile("s_waitcnt vmcnt(0)" ::: "memory");
        __syncthreads();
        cur = nxt; buf ^= 1;
    }
}

template <int MODE>
DEV void attn_store(const Params& p, const AttnItem it, const AttnState& st, const float (&scl)[NQS], int h, int wq, int fr, int fq) {
#pragma unroll
    for (int qs = 0; qs < NQS; ++qs) {
        const size_t tok = (size_t)(it.b * S_ + it.t0 + wq * QW + 16 * qs + fr);
        float* yp = WSF(O_YPART) + tok * 1024 + h * 128 + 4 * fq;
#pragma unroll
        for (int dt = 0; dt < 8; ++dt) {
            f32x4 v = st.O[qs][dt] * scl[qs];
            if (MODE == 0) *(f32x4*)(yp + 16 * dt) = v;
            else if (MODE == 1) { const f32x4 o = *(const f32x4*)(yp + 16 * dt); *(f32x4*)(yp + 16 * dt) = o + v; }
            else { const f32x4 o = *(const f32x4*)(yp + 16 * dt); v += o; u32x2 w2; w2.x = cvt_pk_bf16(v[0], v[1]); w2.y = cvt_pk_bf16(v[2], v[3]);
                *(u32x2*)(WSB(O_CAT) + tok * 2048 + 1024 + h * 128 + 16 * dt + 4 * fq) = w2; }
        }
    }
}

DEV void attn_setup(const Params& p, const AttnItem it, bf16x8 (&qf)[NQS][4], int (&tq)[NQS], float (&ctq)[NQS], float& slope2, int& h, int& wq, int fr, int fq) {
    const int w = threadIdx.x >> 6; wq = w & 1; const int r = w >> 1; h = it.g * 4 + r;
    slope2 = fexp2(-(float)(h + 1)) * 1.4426950408889634f;
#pragma unroll
    for (int qs = 0; qs < NQS; ++qs) {
        tq[qs] = it.t0 + wq * QW + 16 * qs + fr; ctq[qs] = -slope2 * (float)tq[qs];
        const bf16_t* qp = WSB(O_PROJ) + (size_t)(it.b * S_ + tq[qs]) * LDP + Q_OFF + h * 128 + 8 * fq;
#pragma unroll
        for (int ks = 0; ks < 4; ++ks) qf[qs][ks] = *(const bf16x8*)(qp + 32 * ks);
    }
}
DEV void attn_reset(AttnState& st) {
#pragma unroll
    for (int qs = 0; qs < NQS; ++qs) { st.m[qs] = -1e30f; st.l[qs] = 0.f; st.invl[qs] = 0.f;
#pragma unroll
        for (int dt = 0; dt < 8; ++dt) st.O[qs][dt] = (f32x4){0.f, 0.f, 0.f, 0.f}; }
}
DEV float gate_of(const Params& p, const AttnItem it, int tqv, int h, int br) { return sigmoid_f(bf2f(WSB(O_PROJ)[(size_t)(it.b * S_ + tqv) * LDP + GT_OFF + h * 3 + br])); }
DEV void attn_finish_l(AttnState& st) {
#pragma unroll
    for (int qs = 0; qs < NQS; ++qs) { float lt = st.l[qs]; lt += __shfl_xor(lt, 16); lt += __shfl_xor(lt, 32); st.invl[qs] = lt > 0.f ? 1.0f / lt : 0.f; }
}

DEV void window_item(const Params& p, unsigned char* shm, int item) {
    const int lane = threadIdx.x & 63, fr = lane & 15, fq = lane >> 4;
    constexpr int NQT = S_ / QI;
    AttnItem it; it.b = item / (2 * NQT); it.g = (item / NQT) & 1; const int qt = item % NQT; it.t0 = qt * QI;
    bf16x8 qf[NQS][4]; int tq[NQS]; float ctq[NQS]; float slope2; int h, wq;
    attn_setup(p, it, qf, tq, ctq, slope2, h, wq, fr, fq);
    AttnState st; attn_reset(st);
    attn_branch<0>(p, shm, it, qf, st, tq, ctq, slope2, (it.t0 >> 6) >= 8 ? 0 : 8 - (it.t0 >> 6));
    attn_finish_l(st);
    float scl[NQS];
#pragma unroll
    for (int qs = 0; qs < NQS; ++qs) scl[qs] = st.invl[qs] * gate_of(p, it, tq[qs], h, 2);
    attn_store<0>(p, it, st, scl, h, wq, fr, fq);
}

DEV void cmpsel_item(const Params& p, unsigned char* shm, int item) {
    const int tid = threadIdx.x, lane = tid & 63, fr = lane & 15, fq = lane >> 4, w = tid >> 6;
    constexpr int NQT = S_ / QI;
    AttnItem it; const int combo = item / NQT, c = item % NQT, rnd = c >> 8; it.b = combo >> 1; it.g = combo & 1; const int cl = c & 255; const int qt = ((combo ^ rnd) & 1) ? NQT - 1 - cl : cl; it.t0 = qt * QI;
    unsigned* imp = (unsigned*)(shm + A_IMP); unsigned* mask = (unsigned*)(shm + A_MASK); unsigned* uni = (unsigned*)(shm + A_UNI);
    for (int i = tid; i < QI * IMP_STR; i += 512) imp[i] = 0u;
    if (tid < 8) uni[tid] = 0u;
    bf16x8 qf[NQS][4]; int tq[NQS]; float ctq[NQS]; float slope2; int h, wq;
    attn_setup(p, it, qf, tq, ctq, slope2, h, wq, fr, fq);
    AttnState st; attn_reset(st);
    int cnt = (it.t0 + QI - 32) / 16 + 1; if (cnt > 1024) cnt = 1024; const int ntile = (cnt + 63) >> 6;
#ifndef PROBE_NO_CMP
    attn_branch<1>(p, shm, it, qf, st, tq, ctq, slope2, ntile);
    attn_finish_l(st);
    attn_branch<2>(p, shm, it, qf, st, tq, ctq, slope2, ntile);
#endif
    {
        float scl[NQS];
#pragma unroll
        for (int qs = 0; qs < NQS; ++qs) scl[qs] = gate_of(p, it, tq[qs], h, 0);
#ifdef PROBE_NO_SEL
        attn_store<2>(p, it, st, scl, h, wq, fr, fq);
        __syncthreads();
        return;
#else
        attn_store<1>(p, it, st, scl, h, wq, fr, fq);
#endif
    }
    for (int qi = 0; qi < QI / 8; ++qi) {
        const int q = w * (QI / 8) + qi, t = it.t0 + q, cur = t >> 6;
        const u32x4 v = *(const u32x4*)(imp + q * IMP_STR + 4 * lane);
        unsigned long long key[4];
#pragma unroll
        for (int i = 0; i < 4; ++i) { const int J = 4 * lane + i; const bool forced = (J == 0) | (J == cur) | (J == cur - 1);
            const unsigned val = forced ? 0xFFFFFFFFu : v[i];
            key[i] = (J <= cur) ? (((unsigned long long)val << 32) | (unsigned)(256 - J)) : 0ull; }
        unsigned myword = 0u;
        for (int itn = 0; itn < 16; ++itn) {
            unsigned long long best = key[0] > key[1] ? key[0] : key[1]; const unsigned long long b2 = key[2] > key[3] ? key[2] : key[3]; best = best > b2 ? best : b2;
#pragma unroll
            for (int o = 32; o >= 1; o >>= 1) { const unsigned long long ot = __shfl_xor(best, o); best = best > ot ? best : ot; }
            if ((__builtin_amdgcn_readfirstlane((int)(unsigned)(best >> 32)) | __builtin_amdgcn_readfirstlane((int)(unsigned)best)) == 0) break;
            const int J = 256 - (int)(unsigned)(best & 0xffffffffull);
#pragma unroll
            for (int i = 0; i < 4; ++i) if (4 * lane + i == J) key[i] = 0ull;
            if (lane == (J >> 5)) myword |= 1u << (J & 31);
        }
        if (lane < 8) mask[q * 8 + lane] = myword;
    }
    __syncthreads();
    if (tid < QI * 8) atomicOr(uni + (tid & 7), mask[tid]);
    __syncthreads();
    attn_reset(st);
    attn_branch<3>(p, shm, it, qf, st, tq, ctq, slope2, 0);
    attn_finish_l(st);
    {
        float scl[NQS];
#pragma unroll
        for (int qs = 0; qs < NQS; ++qs) scl[qs] = st.invl[qs] * gate_of(p, it, tq[qs], h, 1);
        attn_store<2>(p, it, st, scl, h, wq, fr, fq);
    }
    __syncthreads();
}

DEV void phase_conv(const Params& p) {
    const size_t nvec = (size_t)T_ * DM / 8;
    for (size_t i = (size_t)blockIdx.x * 512 + threadIdx.x; i < nvec; i += (size_t)gridDim.x * 512) {
        const size_t tok = i >> 8; const int c0 = (int)(i & 255) * 8; const int s = (int)(tok & (S_ - 1));
        const u32x4 z2 = *(const u32x4*)(WSB(O_ZZ) + tok * DM + c0);
        u32x4 z1 = (u32x4){0u, 0u, 0u, 0u}, z0 = (u32x4){0u, 0u, 0u, 0u};
        if (s >= 1) z1 = *(const u32x4*)(WSB(O_ZZ) + (tok - 1) * DM + c0);
        if (s >= 2) z0 = *(const u32x4*)(WSB(O_ZZ) + (tok - 2) * DM + c0);
        const u32x4 bgv = *(const u32x4*)(WSB(O_BG) + tok * DM + c0);
        float r[8];
#pragma unroll
        for (int e = 0; e < 8; ++e) {
            const int c = c0 + e; const unsigned sh = (e & 1) ? 16u : 0u;
            const float a0 = bf2f((z0[e >> 1] >> sh) & 0xffffu), a1 = bf2f((z1[e >> 1] >> sh) & 0xffffu), a2 = bf2f((z2[e >> 1] >> sh) & 0xffffu), bb = bf2f((bgv[e >> 1] >> sh) & 0xffffu);
            r[e] = bb * (p.in[16][c] * a0 + p.in[16][DM + c] * a1 + p.in[16][2 * DM + c] * a2);
        }
        u32x4 o; o.x = cvt_pk_bf16(r[0], r[1]); o.y = cvt_pk_bf16(r[2], r[3]); o.z = cvt_pk_bf16(r[4], r[5]); o.w = cvt_pk_bf16(r[6], r[7]);
        *(u32x4*)(WSB(O_MIX) + tok * DM + c0) = o;
    }
}

__global__ void __launch_bounds__(512, 2) mega(Params p, int ph_lo, int ph_hi, int coop) {
    extern __shared__ __attribute__((aligned(16))) unsigned char shm[];
    cg::grid_group grid = cg::this_grid();
#define PH_BEGIN(n) if (ph_lo <= (n) && (n) < ph_hi) {
#define PH_END(n) } if (coop && ph_lo <= (n) && (n) + 1 < ph_hi) { __builtin_amdgcn_fence(__ATOMIC_RELEASE, "agent"); asm volatile("s_waitcnt vmcnt(0) lgkmcnt(0)" ::: "memory"); grid.sync(); __builtin_amdgcn_fence(__ATOMIC_ACQUIRE, "agent"); }
    PH_BEGIN(0) phase_prep(p, shm); PH_END(0)
    PH_BEGIN(1)
        pg8::EpiBf16Act e1; e1.O = WSB(O_PROJ); e1.ldc = LDP; e1.gelu_tiles = 8;
        run_gemm(shm, WSB(O_HN), WSB(O_WIN), T_, LDP, DM, e1);
        pg8::EpiBf16Act e2; e2.O = WSB(O_VT); e2.ldc = T_; e2.gelu_tiles = 0;
        run_gemm(shm, WSB(O_WV), WSB(O_HN), 512, T_, DM, e2);
    PH_END(1)
    PH_BEGIN(2)
        for (int it = blockIdx.x; it < 256; it += gridDim.x) compress_item(p, shm, it);
        for (int it = blockIdx.x; it < 2048; it += gridDim.x) sgu_item(p, shm, it);
        for (int it = blockIdx.x; it < 4 * (S_ / QI); it += gridDim.x) window_item(p, shm, it);
    PH_END(2)
    PH_BEGIN(3) for (int it = blockIdx.x; it < 4 * (S_ / QI); it += gridDim.x) cmpsel_item(p, shm, it); PH_END(3)
    PH_BEGIN(4) pg8::EpiResid e; e.C = p.out; e.R = p.in[0]; e.ldc = DM; run_gemm(shm, WSB(O_CAT), WSB(O_WOUT), T_, DM, DM, e); PH_END(4)
    PH_BEGIN(5) rmsnorm_rows(p.out, p.in[2], WSB(O_HN), nullptr); PH_END(5)
    PH_BEGIN(6) pg8::EpiPair e; e.O = WSB(O_ACT); e.ldc = DFF; e.mode = 0; e.O0 = nullptr; e.ldc0 = 0; e.plain_tiles = 0; run_gemm(shm, WSB(O_HN), WSB(O_WGU0), T_, 2 * DFF, DM, e); PH_END(6)
    PH_BEGIN(7) pg8::EpiResid e; e.C = p.out; e.R = p.out; e.ldc = DM; run_gemm(shm, WSB(O_ACT), WSB(O_WDN0), T_, DM, DFF, e); PH_END(7)
    PH_BEGIN(8) rmsnorm_rows(p.out, p.in[1] + DM, WSB(O_HN), nullptr); PH_END(8)
    PH_BEGIN(9) pg8::EpiPair e; e.O = WSB(O_ZZ); e.ldc = DM; e.mode = 1; e.O0 = WSB(O_BG); e.ldc0 = DM; e.plain_tiles = 8; run_gemm(shm, WSB(O_HN), WSB(O_WINC), T_, 6144, DM, e); PH_END(9)
    PH_BEGIN(10) phase_conv(p); PH_END(10)
    PH_BEGIN(11) pg8::EpiResid e; e.C = p.out; e.R = p.out; e.ldc = DM; run_gemm(shm, WSB(O_MIX), WSB(O_WOUTC), T_, DM, DM, e); PH_END(11)
    PH_BEGIN(12) rmsnorm_rows(p.out, p.in[2] + DM, WSB(O_HN), nullptr); PH_END(12)
    PH_BEGIN(13) pg8::EpiPair e; e.O = WSB(O_ACT); e.ldc = DFF; e.mode = 0; e.O0 = nullptr; e.ldc0 = 0; e.plain_tiles = 0; run_gemm(shm, WSB(O_HN), WSB(O_WGU1), T_, 2 * DFF, DM, e); PH_END(13)
    PH_BEGIN(14) pg8::EpiResid e; e.C = p.out; e.R = p.out; e.ldc = DM; run_gemm(shm, WSB(O_ACT), WSB(O_WDN1), T_, DM, DFF, e); PH_END(14)
    PH_BEGIN(15) rmsnorm_rows(p.out, p.in[3], nullptr, p.out); PH_END(15)
#ifdef DUMP_OFF
    if (ph_hi < 16) { __builtin_amdgcn_fence(__ATOMIC_RELEASE, "agent"); grid.sync(); __builtin_amdgcn_fence(__ATOMIC_ACQUIRE, "agent");
        const size_t half = (size_t)T_ * 1024;
        for (size_t i = (size_t)blockIdx.x * 512 + threadIdx.x; i < 2 * half; i += (size_t)gridDim.x * 512) {
            float v;
            v = bf2f(WSB(O_CAT)[i]);
            p.out[i] = v; } }
#endif
}
constexpr int NPHASE = 16;

extern "C" void kernel_launch(void* const* d_in, const int* in_sizes, int n_in, void* d_out, int out_size, void* d_ws, size_t ws_size, hipStream_t stream) {
    static int grid_blocks = 0;
    if (!grid_blocks) {
        int dev = 0, cus = 0, per_cu = 0;
        hipGetDevice(&dev);
        hipDeviceGetAttribute(&cus, hipDeviceAttributeMultiprocessorCount, dev);
        hipFuncSetAttribute((const void*)mega, hipFuncAttributeMaxDynamicSharedMemorySize, LDS_BYTES);
        hipOccupancyMaxActiveBlocksPerMultiprocessor(&per_cu, (const void*)mega, 512, LDS_BYTES);
        if (per_cu < 1) { fprintf(stderr, "occupancy query returned %d\n", per_cu); per_cu = 1; }
        grid_blocks = cus * per_cu;
        (void)hipGetLastError();
    }
    Params p{};
    for (int i = 0; i < 21; ++i) p.in[i] = (const float*)d_in[i];
    p.out = (float*)d_out; p.ws = (unsigned char*)d_ws;
    if (WS_END > ws_size || n_in != 21) { fprintf(stderr, "workspace too small / bad inputs: need %zu have %zu, n_in %d\n", (size_t)WS_END, ws_size, n_in); return; }
    #ifdef DUMP_HI
    int lo = 0, hi = DUMP_HI, coop = 1;
#else
    int lo = 0, hi = NPHASE, coop = 1;
#endif
    void* args[] = {&p, &lo, &hi, &coop};
    hipError_t e = hipLaunchCooperativeKernel((const void*)mega, dim3(grid_blocks), dim3(512), args, LDS_BYTES, stream);
    if (e != hipSuccess) fprintf(stderr, "cooperative launch failed: %s (grid %d)\n", hipGetErrorString(e), grid_blocks);
}
```

```cpp
#include <hip/hip_runtime.h>
#include <hip/hip_cooperative_groups.h>
#include <cstdio>
namespace cg = cooperative_groups;

#define DEV __device__ __forceinline__
#define LAS __attribute__((address_space(3)))
typedef unsigned short bf16_t;
typedef short bf16x8 __attribute__((ext_vector_type(8)));
typedef float f32x4 __attribute__((ext_vector_type(4)));
typedef float f32x2 __attribute__((ext_vector_type(2)));
typedef unsigned u32x4 __attribute__((ext_vector_type(4)));
typedef unsigned u32x2 __attribute__((ext_vector_type(2)));

constexpr int S_ = 16384, T_ = 32768, DM = 2048, DFF = 5632;
constexpr int LDP = 4352;
constexpr int U_OFF = 0, V_OFF = 1024, Q_OFF = 2048, KC_OFF = 3072, VC_OFF = 3328, KS_OFF = 3584, KW_OFF = 3840, GT_OFF = 4096;
constexpr int LDS_BYTES = 141312;
constexpr float EPS = 1e-6f;

struct Params { const float* in[21]; float* out; unsigned char* ws; };
constexpr size_t al256(size_t x) { return (x + 255) & ~(size_t)255; }
constexpr size_t O_WIN = 0;
constexpr size_t O_WV = O_WIN + al256((size_t)LDP * DM * 2);
constexpr size_t O_WOUT = O_WV + al256((size_t)512 * DM * 2);
constexpr size_t O_WGU0 = O_WOUT + al256((size_t)DM * DM * 2);
constexpr size_t O_WGU1 = O_WGU0 + al256((size_t)2 * DFF * DM * 2);
constexpr size_t O_WDN0 = O_WGU1 + al256((size_t)2 * DFF * DM * 2);
constexpr size_t O_WDN1 = O_WDN0 + al256((size_t)DM * DFF * 2);
constexpr size_t O_WINC = O_WDN1 + al256((size_t)DM * DFF * 2);
constexpr size_t O_WOUTC = O_WINC + al256((size_t)6144 * DM * 2);
constexpr size_t O_W1K = O_WOUTC + al256((size_t)DM * DM * 2);
constexpr size_t O_W1V = O_W1K + al256((size_t)128 * 4096 * 2);
constexpr size_t O_W2K = O_W1V + al256((size_t)128 * 4096 * 2);
constexpr size_t O_W2V = O_W2K + al256(128 * 128 * 2);
constexpr size_t O_SGUW = O_W2V + al256(128 * 128 * 2);
constexpr size_t O_CBIAS = O_SGUW + al256(8 * 128 * 128 * 2);
constexpr size_t O_KCMP = O_CBIAS + 8192;
constexpr size_t O_VCMPT = O_KCMP + al256((size_t)4 * 1024 * 128 * 2);
constexpr size_t O_HN = O_VCMPT + al256((size_t)4 * 128 * 1024 * 2);
constexpr size_t O_BIG = O_HN + al256((size_t)T_ * DM * 2);
constexpr size_t O_PROJ = O_BIG;
constexpr size_t O_VT = O_PROJ + al256((size_t)(T_ + 32) * LDP * 2);
constexpr size_t O_CAT = O_VT + al256((size_t)512 * T_ * 2);
constexpr size_t O_YPART = O_CAT + al256((size_t)T_ * DM * 2);
constexpr size_t WS_END = O_YPART + al256((size_t)T_ * 1024 * 4);
constexpr size_t O_ACT = O_BIG;
constexpr size_t O_BG = O_BIG;
constexpr size_t O_ZZ = O_BG + al256((size_t)T_ * DM * 2);
constexpr size_t O_MIX = O_ZZ + al256((size_t)T_ * DM * 2);
static_assert(O_ACT + (size_t)T_ * DFF * 2 <= WS_END && O_MIX + (size_t)T_ * DM * 2 <= WS_END, "ws alias");
constexpr size_t O_HRES = O_YPART;
constexpr size_t WS_NEED = WS_END + 256;
#define WSB(off) ((bf16_t*)(p.ws + (off)))
#define WSF(off) ((float*)(p.ws + (off)))

DEV float bf2f(unsigned h) { return __uint_as_float(h << 16); }
DEV unsigned cvt_pk_bf16(float lo, float hi) { unsigned r; asm("v_cvt_pk_bf16_f32 %0, %1, %2" : "=v"(r) : "v"(lo), "v"(hi)); return r; }
DEV float fexp2(float x) { return __builtin_amdgcn_exp2f(x); }
DEV float frcp(float x) { return __builtin_amdgcn_rcpf(x); }
DEV float gelu_t(float x) { const float u = x * (1.0f + 0.044715f * x * x); return x * frcp(1.0f + fexp2(-2.3022082f * u)); }
DEV float silu_f(float x) { return x * frcp(1.0f + fexp2(-1.4426950409f * x)); }
DEV float sigmoid_f(float x) { return frcp(1.0f + fexp2(-1.4426950409f * x)); }
DEV f32x4 mfma16(bf16x8 a, bf16x8 b, f32x4 c) { return __builtin_amdgcn_mfma_f32_16x16x32_bf16(a, b, c, 0, 0, 0); }

namespace pg8 {
constexpr int BM = 256, BK = 64, HALF = 128, HTB = HALF * BK * 2, STAGE_BYTES = 8 * HTB, NXCD = 8, WGM = 8;
DEV int lds_byte(int r, int c) { const int st = (r >> 4) * 2 + (c >> 5), rr = r & 15, cc = c & 31, ob = rr * 64 + cc * 2; return st * 1024 + (ob ^ (((ob >> 9) & 1) << 5)); }
DEV void stage_rc(int b, int& R, int& C) { const int st = b / 1024, sb = b % 1024, swz = sb ^ (((sb >> 9) & 1) << 5); R = (st >> 1) * 16 + swz / 64; C = (st & 1) * 32 + (swz % 64) / 2; }
DEV int perm32(int rho) { const int n = rho >> 4, i = rho & 15; return 8 * (i >> 2) + 4 * n + (i & 3); }
struct Unit { int pm, pn; };
struct Gemm { const bf16_t* A; const bf16_t* Bt; int M, N, K; };
struct StaticOrder {
    int nM, nN, nwg, G, c;
    DEV void init(int M, int N, int G_, int c_) { nM = M / BM; nN = N / BM; nwg = nM * nN; G = G_; c = c_; }
    DEV bool next(int i, Unit& u) const {
        const long L = (long)i * G + c; if (L >= nwg) return false;
        int wgid = (int)L; { const int q = nwg / NXCD, r = nwg % NXCD, xcd = wgid % NXCD, off = wgid / NXCD; wgid = (xcd < r ? xcd * (q + 1) : r * (q + 1) + (xcd - r) * q) + off; }
        const int nig = WGM * nN, gid = wgid / nig, fm = gid * WGM, gsz = (nM - fm) < WGM ? (nM - fm) : WGM;
        u.pm = fm + ((wgid % nig) % gsz); u.pn = (wgid % nig) / gsz; return true;
    }
};

template <class Epi>
DEV void gemm_phase(LAS unsigned char* lds, const Gemm g, const StaticOrder& S, const Epi& E) {
    const int tid = threadIdx.x, wid = __builtin_amdgcn_readfirstlane(tid >> 6), lane = tid & 63, wr = wid >> 2, wc = wid & 3, fr = lane & 15, fq = lane >> 4;
    const int K = g.K, nt = K / BK;
    unsigned voffA[2], voffB[2];
#pragma unroll
    for (int i = 0; i < 2; ++i) { int R, C; stage_rc(tid * 16 + i * 8192, R, C); const int Rb = Epi::PERM ? ((R & ~31) + perm32(R & 31)) : R;
        voffA[i] = (unsigned)(R * K + C) * 2u; voffB[i] = (unsigned)(Rb * K + C) * 2u; }
    const size_t kstep = (size_t)(BK * 2);
    const size_t hstep = (size_t)HALF * K * 2;
    const size_t tstep = 2 * hstep;
    const unsigned ldsw = (unsigned)wid * 1024u;
    const int aoff = lds_byte(wr * 64 + fr, fq * 8), boff = lds_byte(wc * 32 + fr, fq * 8);
#define PG8_SA(b, h) (((b) * 2 + (h)) * HTB)
#define PG8_SB(b, h) ((4 + (b) * 2 + (h)) * HTB)
#define PG8_STAGE(bufoff, gbase, voff) do { _Pragma("unroll") for (int _i = 0; _i < 2; ++_i) \
        __builtin_amdgcn_global_load_lds((const unsigned*)((const char*)(gbase) + (voff)[_i]), (LAS unsigned*)(lds + (bufoff) + ldsw + _i * 8192), 16, 0, 0); } while (0)
#define PG8_LDA(dst, b, h) do { _Pragma("unroll") for (int m = 0; m < 4; ++m) _Pragma("unroll") for (int k = 0; k < 2; ++k) dst[m][k] = *(const LAS bf16x8*)(lds + PG8_SA(b, h) + aoff + m * 2048 + k * 1024); } while (0)
#define PG8_LDB(dst, b, h) do { _Pragma("unroll") for (int n = 0; n < 2; ++n) _Pragma("unroll") for (int k = 0; k < 2; ++k) dst[n][k] = *(const LAS bf16x8*)(lds + PG8_SB(b, h) + boff + n * 2048 + k * 1024); } while (0)
#define PG8_MMA(ai, bj, At, Bt) do { __builtin_amdgcn_s_setprio(1); _Pragma("unroll") for (int m = 0; m < 4; ++m) _Pragma("unroll") for (int n = 0; n < 2; ++n) _Pragma("unroll") for (int k = 0; k < 2; ++k) \
        acc[ai][bj][m][n] = __builtin_amdgcn_mfma_f32_16x16x32_bf16(Bt[n][k], At[m][k], acc[ai][bj][m][n], 0, 0, 0); __builtin_amdgcn_s_setprio(0); } while (0)
#define PG8_WAIT_V(n) asm volatile("s_waitcnt vmcnt(" #n ")" ::: "memory")
#define PG8_WAIT_L(n) asm volatile("s_waitcnt lgkmcnt(" #n ")" ::: "memory")
#define PG8_BAR __builtin_amdgcn_s_barrier()
#define PG8_SCHED __builtin_amdgcn_sched_barrier(0)
    Unit cur, nxt; int ui = 0;
    if (!S.next(0, cur)) return;
    f32x4 acc[2][2][4][2];
#pragma unroll
    for (int a = 0; a < 2; ++a)
#pragma unroll
        for (int b = 0; b < 2; ++b)
#pragma unroll
            for (int m = 0; m < 4; ++m)
#pragma unroll
                for (int n = 0; n < 2; ++n) acc[a][b][m][n] = (f32x4){0.f, 0.f, 0.f, 0.f};
    bf16x8 At[4][2], B0[2][2], B1[2][2];
    const char* cA = (const char*)g.A + (size_t)cur.pm * tstep; const char* cB = (const char*)g.Bt + (size_t)cur.pn * tstep;
    PG8_STAGE(PG8_SB(0, 0), cB, voffB); PG8_STAGE(PG8_SA(0, 0), cA, voffA); PG8_STAGE(PG8_SB(0, 1), cB + hstep, voffB); PG8_STAGE(PG8_SA(0, 1), cA + hstep, voffA);
    if (wr == 1) PG8_BAR;
    PG8_WAIT_V(4); PG8_BAR;
    PG8_STAGE(PG8_SB(1, 0), cB + kstep, voffB); PG8_STAGE(PG8_SA(1, 0), cA + kstep, voffA); PG8_STAGE(PG8_SB(1, 1), cB + hstep + kstep, voffB);
    PG8_WAIT_V(6); PG8_BAR;
    for (;;) {
        const bool has_next = S.next(ui + 1, nxt);
        const char* nA = has_next ? (const char*)g.A + (size_t)nxt.pm * tstep : cA; const char* nB = has_next ? (const char*)g.Bt + (size_t)nxt.pn * tstep : cB;
        for (int t = 0; t < nt; t += 2) {
            const bool last = (t == nt - 2);
            const char* a1 = cA + (size_t)(t + 1) * kstep;
            const char* a2 = last ? nA : cA + (size_t)(t + 2) * kstep; const char* b2 = last ? nB : cB + (size_t)(t + 2) * kstep;
            const char* a3 = a2 + kstep; const char* b3 = b2 + kstep;
            PG8_LDB(B0, 0, 0); PG8_SCHED; PG8_LDA(At, 0, 0); PG8_STAGE(PG8_SA(1, 1), a1 + hstep, voffA);
            PG8_WAIT_L(8); PG8_BAR; PG8_WAIT_L(0); PG8_MMA(0, 0, At, B0); PG8_BAR; PG8_SCHED;
            PG8_LDB(B1, 0, 1); PG8_STAGE(PG8_SB(0, 0), b2, voffB);
            PG8_BAR; PG8_WAIT_L(0); PG8_MMA(0, 1, At, B1); PG8_BAR;
            PG8_LDA(At, 0, 1); PG8_STAGE(PG8_SA(0, 0), a2, voffA);
            PG8_BAR; PG8_WAIT_L(0); PG8_MMA(1, 0, At, B0); PG8_BAR; PG8_SCHED;
            PG8_STAGE(PG8_SB(0, 1), b2 + hstep, voffB);
            PG8_WAIT_V(6); PG8_BAR; PG8_MMA(1, 1, At, B1); PG8_BAR;
            PG8_LDB(B0, 1, 0); PG8_SCHED; PG8_LDA(At, 1, 0); PG8_STAGE(PG8_SA(0, 1), a2 + hstep, voffA);
            PG8_WAIT_L(8); PG8_BAR; PG8_WAIT_L(0); PG8_MMA(0, 0, At, B0); PG8_BAR; PG8_SCHED;
            PG8_LDB(B1, 1, 1); PG8_STAGE(PG8_SB(1, 0), b3, voffB);
            PG8_BAR; PG8_WAIT_L(0); PG8_MMA(0, 1, At, B1); PG8_BAR;
            PG8_LDA(At, 1, 1); PG8_STAGE(PG8_SA(1, 0), a3, voffA);
            PG8_BAR; PG8_WAIT_L(0); PG8_MMA(1, 0, At, B0); PG8_BAR; PG8_SCHED;
            PG8_STAGE(PG8_SB(1, 1), b3 + hstep, voffB);
            PG8_WAIT_V(6); PG8_BAR; PG8_MMA(1, 1, At, B1); PG8_BAR;
        }
        E(acc, cur, wr, wc, fr, fq);
        if (!has_next) break;
#pragma unroll
        for (int a = 0; a < 2; ++a)
#pragma unroll
            for (int b = 0; b < 2; ++b)
#pragma unroll
                for (int m = 0; m < 4; ++m)
#pragma unroll
                    for (int n = 0; n < 2; ++n) acc[a][b][m][n] = (f32x4){0.f, 0.f, 0.f, 0.f};
        cur = nxt; cA = nA; cB = nB; ++ui;
    }
    PG8_WAIT_V(0);
    if (wr == 0) PG8_BAR;
    PG8_BAR;
#undef PG8_SA
#undef PG8_SB
#undef PG8_STAGE
#undef PG8_LDA
#undef PG8_LDB
#undef PG8_MMA
#undef PG8_WAIT_V
#undef PG8_WAIT_L
#undef PG8_BAR
#undef PG8_SCHED
}

struct EpiBf16Act {
    static constexpr bool PERM = true;
    bf16_t* O; int ldc; int gelu_tiles;
    DEV void operator()(const f32x4 (&acc)[2][2][4][2], const Unit& u, int wr, int wc, int fr, int fq) const {
        const int row0 = u.pm * BM + wr * 64 + fr, col0 = u.pn * BM + wc * 32 + 8 * fq;
        const bool act = u.pn < gelu_tiles;
#pragma unroll
        for (int ai = 0; ai < 2; ++ai)
#pragma unroll
            for (int m = 0; m < 4; ++m) { bf16_t* rowp = O + (size_t)(row0 + ai * HALF + m * 16) * ldc + col0;
#pragma unroll
                for (int bj = 0; bj < 2; ++bj) { f32x4 v0 = acc[ai][bj][m][0], v1 = acc[ai][bj][m][1];
                    if (act) {
#pragma unroll
                        for (int j = 0; j < 4; ++j) { v0[j] = gelu_t(v0[j]); v1[j] = gelu_t(v1[j]); } }
                    u32x4 w; w.x = cvt_pk_bf16(v0[0], v0[1]); w.y = cvt_pk_bf16(v0[2], v0[3]); w.z = cvt_pk_bf16(v1[0], v1[1]); w.w = cvt_pk_bf16(v1[2], v1[3]);
                    *(u32x4*)(rowp + bj * HALF) = w; } }
    }
};
struct EpiPair {
    static constexpr bool PERM = true;
    bf16_t* O; int ldc; int mode; bf16_t* O0; int ldc0; int plain_tiles;
    DEV void operator()(const f32x4 (&acc)[2][2][4][2], const Unit& u, int wr, int wc, int fr, int fq) const {
        const int row0 = u.pm * BM + wr * 64 + fr;
        if (mode == 1 && u.pn < plain_tiles) {
            const int col0 = u.pn * BM + wc * 32 + 8 * fq;
#pragma unroll
            for (int ai = 0; ai < 2; ++ai)
#pragma unroll
                for (int m = 0; m < 4; ++m) { bf16_t* rowp = O0 + (size_t)(row0 + ai * HALF + m * 16) * ldc0 + col0;
#pragma unroll
                    for (int bj = 0; bj < 2; ++bj) { const f32x4 v0 = acc[ai][bj][m][0], v1 = acc[ai][bj][m][1];
                        u32x4 w; w.x = cvt_pk_bf16(v0[0], v0[1]); w.y = cvt_pk_bf16(v0[2], v0[3]); w.z = cvt_pk_bf16(v1[0], v1[1]); w.w = cvt_pk_bf16(v1[2], v1[3]);
                        *(u32x4*)(rowp + bj * HALF) = w; } }
            return;
        }
        const int pt = (mode == 1) ? (u.pn - plain_tiles) : u.pn;
        const int col0 = pt * HALF + wc * 32 + 8 * fq;
#pragma unroll
        for (int ai = 0; ai < 2; ++ai)
#pragma unroll
            for (int m = 0; m < 4; ++m) { bf16_t* rowp = O + (size_t)(row0 + ai * HALF + m * 16) * ldc + col0;
                f32x4 r0, r1;
#pragma unroll
                for (int j = 0; j < 4; ++j) {
                    const float a0 = acc[ai][0][m][0][j], a1 = acc[ai][0][m][1][j], b0 = acc[ai][1][m][0][j], b1 = acc[ai][1][m][1][j];
                    r0[j] = (mode == 0 ? silu_f(a0) : a0) * b0; r1[j] = (mode == 0 ? silu_f(a1) : a1) * b1; }
                u32x4 w; w.x = cvt_pk_bf16(r0[0], r0[1]); w.y = cvt_pk_bf16(r0[2], r0[3]); w.z = cvt_pk_bf16(r1[0], r1[1]); w.w = cvt_pk_bf16(r1[2], r1[3]);
                *(u32x4*)rowp = w; }
    }
};
struct EpiResid {
    static constexpr bool PERM = false;
    float* C; const float* R; int ldc;
    DEV void operator()(const f32x4 (&acc)[2][2][4][2], const Unit& u, int wr, int wc, int fr, int fq) const {
        const int row0 = u.pm * BM + wr * 64 + fr, col0 = u.pn * BM + wc * 32 + 4 * fq;
#pragma unroll
        for (int ai = 0; ai < 2; ++ai)
#pragma unroll
            for (int m = 0; m < 4; ++m) { const size_t ro = (size_t)(row0 + ai * HALF + m * 16) * ldc + col0;
#pragma unroll
                for (int bj = 0; bj < 2; ++bj)
#pragma unroll
                    for (int n = 0; n < 2; ++n) { const f32x4 r = *(const f32x4*)(R + ro + bj * HALF + n * 16); *(f32x4*)(C + ro + bj * HALF + n * 16) = acc[ai][bj][m][n] + r; } }
    }
};
struct EpiResidB {
    static constexpr bool PERM = true;
    bf16_t* C; const float* Rf; const bf16_t* Rb; int ldc;
    DEV void operator()(const f32x4 (&acc)[2][2][4][2], const Unit& u, int wr, int wc, int fr, int fq) const {
        const int row0 = u.pm * BM + wr * 64 + fr, col0 = u.pn * BM + wc * 32 + 8 * fq;
#pragma unroll
        for (int ai = 0; ai < 2; ++ai)
#pragma unroll
            for (int m = 0; m < 4; ++m) { const size_t ro = (size_t)(row0 + ai * HALF + m * 16) * ldc + col0;
#pragma unroll
                for (int bj = 0; bj < 2; ++bj) { f32x4 v0 = acc[ai][bj][m][0], v1 = acc[ai][bj][m][1];
                    if (Rf) { v0 += *(const f32x4*)(Rf + ro + bj * HALF); v1 += *(const f32x4*)(Rf + ro + bj * HALF + 4); }
                    else { const u32x4 r = *(const u32x4*)(Rb + ro + bj * HALF);
                        v0[0] += bf2f(r.x & 0xffffu); v0[1] += bf2f(r.x >> 16); v0[2] += bf2f(r.y & 0xffffu); v0[3] += bf2f(r.y >> 16);
                        v1[0] += bf2f(r.z & 0xffffu); v1[1] += bf2f(r.z >> 16); v1[2] += bf2f(r.w & 0xffffu); v1[3] += bf2f(r.w >> 16); }
                    u32x4 w; w.x = cvt_pk_bf16(v0[0], v0[1]); w.y = cvt_pk_bf16(v0[2], v0[3]); w.z = cvt_pk_bf16(v1[0], v1[1]); w.w = cvt_pk_bf16(v1[2], v1[3]);
                    *(u32x4*)(C + ro + bj * HALF) = w; } }
    }
};
}

template <class Epi>
DEV void run_gemm(unsigned char* shm, const bf16_t* A, const bf16_t* Bt, int M, int N, int K, const Epi& E) {
    pg8::Gemm g; g.A = A; g.Bt = Bt; g.M = M; g.N = N; g.K = K;
    pg8::StaticOrder S; S.init(M, N, (int)gridDim.x, (int)blockIdx.x);
    pg8::gemm_phase<Epi>((LAS unsigned char*)shm, g, S, E);
    __syncthreads();
}

template <class CM>
DEV void transpose_conv(unsigned char* shm, bf16_t* __restrict__ dst, int Nd, int K, int ld, const float* rowscale, const CM cm) {
    float* lt = (float*)shm;
    const int tid = threadIdx.x, tn = Nd >> 6, tk = K >> 6, ntile = tn * tk;
    const int nn = tid & 63, kq = tid >> 6;
    float r[8];
    int tile = blockIdx.x;
    if (tile < ntile) { const int n0 = (tile % tn) << 6, k0 = (tile / tn) << 6; const float* cp = cm(n0 + nn);
#pragma unroll
        for (int i = 0; i < 8; ++i) { const int kk = k0 + kq + 8 * i; float v = cp ? cp[(size_t)kk * ld] : 0.f; if (rowscale) v *= rowscale[kk]; r[i] = v; } }
    while (tile < ntile) {
        const int n0 = (tile % tn) << 6, k0 = (tile / tn) << 6;
#pragma unroll
        for (int i = 0; i < 8; ++i) lt[(kq + 8 * i) * 65 + nn] = r[i];
        __syncthreads();
        const int nxt = tile + gridDim.x;
        if (nxt < ntile) { const int n1 = (nxt % tn) << 6, k1 = (nxt / tn) << 6; const float* cp = cm(n1 + nn);
#pragma unroll
            for (int i = 0; i < 8; ++i) { const int kk = k1 + kq + 8 * i; float v = cp ? cp[(size_t)kk * ld] : 0.f; if (rowscale) v *= rowscale[kk]; r[i] = v; } }
#pragma unroll
        for (int i = 0; i < 4; ++i) { const int pi = tid + 512 * i, n2 = pi >> 5, k2 = (pi & 31) * 2;
            *(unsigned*)(dst + (size_t)(n0 + n2) * K + k0 + k2) = cvt_pk_bf16(lt[k2 * 65 + n2], lt[(k2 + 1) * 65 + n2]); }
        __syncthreads();
        tile = nxt;
    }
}
struct CmPlain { const float* src; DEV const float* operator()(int n) const { return src + n; } };
struct CmWin { const float* src;
    DEV const float* operator()(int n) const { if (n < 3840) return src + n; if (n < 4096) return src + n + 256; if (n < 4120) return src + n + 512; return nullptr; } };
struct CmWv { const float* src; DEV const float* operator()(int n) const { return n < 256 ? src + 3840 + n : src + 4352 + (n - 256); } };
struct CmGU { const float* gate; const float* up; DEV const float* operator()(int n) const { const int pn = n >> 8, bj = (n >> 7) & 1, i = n & 127; const long long diff = (const char*)up - (const char*)gate; return (const float*)((const char*)gate + (long long)bj * diff) + pn * 128 + i; } };
struct CmInC { const float* src; DEV const float* operator()(int n) const { if (n < 2048) return src + n; const int m = n - 2048, pn = m >> 8, bj = (m >> 7) & 1, i = m & 127; return src + 2048 + bj * 2048 + pn * 128 + i; } };

template <bool SRCBF>
DEV void rmsnorm_rows(const void* srcv, const float* gain, bf16_t* dst, float* dstf) {
    const int lane = threadIdx.x & 63, wv = threadIdx.x >> 6;
    f32x4 gv[8];
#pragma unroll
    for (int i = 0; i < 8; ++i) gv[i] = *(const f32x4*)(gain + (i * 64 + lane) * 4);
    const int stride = gridDim.x * 8;
    auto ld4 = [&](int row, int i) -> f32x4 {
        if (SRCBF) { const u32x2 r = *(const u32x2*)((const bf16_t*)srcv + (size_t)row * DM + (i * 64 + lane) * 4);
            return (f32x4){bf2f(r.x & 0xffffu), bf2f(r.x >> 16), bf2f(r.y & 0xffffu), bf2f(r.y >> 16)}; }
        return *(const f32x4*)((const float*)srcv + (size_t)row * DM + (i * 64 + lane) * 4);
    };
    for (int row = blockIdx.x * 8 + wv; row < T_; row += 2 * stride) {
        const int row2 = row + stride; const bool has2 = row2 < T_; const int row2c = has2 ? row2 : row;
        f32x4 v[8], u[8]; float ss = 0.f, ss2 = 0.f;
#pragma unroll
        for (int i = 0; i < 8; ++i) v[i] = ld4(row, i);
#pragma unroll
        for (int i = 0; i < 8; ++i) u[i] = ld4(row2c, i);
#pragma unroll
        for (int i = 0; i < 8; ++i) { ss += v[i][0] * v[i][0] + v[i][1] * v[i][1] + v[i][2] * v[i][2] + v[i][3] * v[i][3]; ss2 += u[i][0] * u[i][0] + u[i][1] * u[i][1] + u[i][2] * u[i][2] + u[i][3] * u[i][3]; }
#pragma unroll
        for (int o = 32; o >= 1; o >>= 1) { ss += __shfl_xor(ss, o); ss2 += __shfl_xor(ss2, o); }
        const float rs = rsqrtf(ss * (1.0f / DM) + EPS), rs2 = rsqrtf(ss2 * (1.0f / DM) + EPS);
#pragma unroll
        for (int i = 0; i < 8; ++i) { const f32x4 y = v[i] * rs * gv[i];
            if (dst) { u32x2 w; w.x = cvt_pk_bf16(y[0], y[1]); w.y = cvt_pk_bf16(y[2], y[3]); *(u32x2*)(dst + (size_t)row * DM + (i * 64 + lane) * 4) = w; }
            else __builtin_nontemporal_store(y, (f32x4*)(dstf + (size_t)row * DM + (i * 64 + lane) * 4)); }
        if (has2) {
#pragma unroll
            for (int i = 0; i < 8; ++i) { const f32x4 y = u[i] * rs2 * gv[i];
                if (dst) { u32x2 w; w.x = cvt_pk_bf16(y[0], y[1]); w.y = cvt_pk_bf16(y[2], y[3]); *(u32x2*)(dst + (size_t)row2 * DM + (i * 64 + lane) * 4) = w; }
                else __builtin_nontemporal_store(y, (f32x4*)(dstf + (size_t)row2 * DM + (i * 64 + lane) * 4)); }
        }
    }
}

DEV void phase_prep(const Params& p, unsigned char* shm) {
    const int tid = threadIdx.x;
    transpose_conv(shm, WSB(O_WIN), 4352, 2048, 4632, nullptr, CmWin{p.in[4]});
    transpose_conv(shm, WSB(O_WV), 512, 2048, 4632, nullptr, CmWv{p.in[4]});
    transpose_conv(shm, WSB(O_WOUT), 2048, 2048, 2048, nullptr, CmPlain{p.in[5]});
    transpose_conv(shm, WSB(O_WGU0), 2 * DFF, 2048, DFF, nullptr, CmGU{p.in[18], p.in[19]});
    transpose_conv(shm, WSB(O_WGU1), 2 * DFF, 2048, DFF, nullptr, CmGU{p.in[18] + (size_t)DM * DFF, p.in[19] + (size_t)DM * DFF});
    transpose_conv(shm, WSB(O_WDN0), 2048, DFF, 2048, nullptr, CmPlain{p.in[20]});
    transpose_conv(shm, WSB(O_WDN1), 2048, DFF, 2048, nullptr, CmPlain{p.in[20] + (size_t)DFF * DM});
    transpose_conv(shm, WSB(O_WINC), 6144, 2048, 6144, nullptr, CmInC{p.in[15]});
    transpose_conv(shm, WSB(O_WOUTC), 2048, 2048, 2048, nullptr, CmPlain{p.in[17]});
    transpose_conv(shm, WSB(O_W1K), 128, 4096, 128, nullptr, CmPlain{p.in[10]});
    transpose_conv(shm, WSB(O_W1V), 128, 4096, 128, nullptr, CmPlain{p.in[13]});
    transpose_conv(shm, WSB(O_W2K), 128, 128, 128, nullptr, CmPlain{p.in[11]});
    transpose_conv(shm, WSB(O_W2V), 128, 128, 128, nullptr, CmPlain{p.in[14]});
    for (int i = blockIdx.x * 512 + tid; i < 8 * 128 * 128; i += gridDim.x * 512) { const int pp = i & 127, t = (i >> 7) & 127; WSB(O_SGUW)[i] = (bf16_t)(cvt_pk_bf16(pp <= t ? p.in[6][i] : 0.f, 0.f) & 0xffffu); }
    if (blockIdx.x < 16) {
        float* red = (float*)shm;
        const int kv = blockIdx.x >> 3, sl = blockIdx.x & 7;
        const float* pe = kv ? p.in[12] : p.in[9]; const float* w1 = kv ? p.in[13] : p.in[10];
        const int e = tid & 127, part = tid >> 7; float sacc = 0.f;
        const int kb = sl * 512 + part * 128;
#pragma unroll 8
        for (int k = kb; k < kb + 128; ++k) sacc += pe[k] * w1[(size_t)k * 128 + e];
        red[part * 128 + e] = sacc; __syncthreads();
        if (tid < 128) WSF(O_CBIAS)[(kv * 8 + sl) * 128 + tid] = red[tid] + red[128 + tid] + red[256 + tid] + red[384 + tid];
        __syncthreads();
    }
    rmsnorm_rows<false>(p.in[0], p.in[1], WSB(O_HN), nullptr);
}

DEV void sgu_item(const Params& p, unsigned char* shm, int item) {
    const int tid = threadIdx.x, w = tid >> 6, lane = tid & 63, fr = lane & 15, fq = lane >> 4;
    const int g = item & 7, n = (item >> 3) & 127, b = item >> 10;
    const int tok0 = b * S_ + n * 128;
    bf16_t* vT = (bf16_t*)shm;
    float* ssq = (float*)(shm + 128 * 136 * 2);
    {
        const int prow = tid & 127, cq = tid >> 7;
        const bf16_t* vp = WSB(O_PROJ) + (size_t)(tok0 + prow) * LDP + V_OFF + g * 128 + cq * 32;
        float f[32]; float ss = 0.f;
#pragma unroll
        for (int i = 0; i < 4; ++i) { const u32x4 raw = *(const u32x4*)(vp + 8 * i);
#pragma unroll
            for (int e = 0; e < 4; ++e) { f[8 * i + 2 * e] = bf2f(raw[e] & 0xffffu); f[8 * i + 2 * e + 1] = bf2f(raw[e] >> 16); } }
#pragma unroll
        for (int e = 0; e < 32; ++e) ss += f[e] * f[e];
        ssq[cq * 128 + prow] = ss;
        __syncthreads();
        const float tot = ssq[prow] + ssq[128 + prow] + ssq[256 + prow] + ssq[384 + prow];
        const float rs = rsqrtf(tot * (1.0f / 128.0f) + EPS);
        const float* gp = p.in[8] + g * 128 + cq * 32;
#pragma unroll
        for (int e = 0; e < 32; ++e) vT[(cq * 32 + e) * 136 + prow] = (bf16_t)(cvt_pk_bf16(f[e] * rs * gp[e], 0.f) & 0xffffu);
    }
    __syncthreads();
    f32x4 acc[8];
#pragma unroll
    for (int ct = 0; ct < 8; ++ct) acc[ct] = (f32x4){0.f, 0.f, 0.f, 0.f};
    const bf16_t* Wg = WSB(O_SGUW) + (size_t)(g * 128 + 16 * w + fr) * 128;
    const int nks = (w >> 1) + 1;
    for (int ks = 0; ks < nks; ++ks) {
        const bf16x8 wf = *(const bf16x8*)(Wg + 32 * ks + 8 * fq);
#pragma unroll
        for (int ct = 0; ct < 8; ++ct) { const bf16x8 vf = *(const bf16x8*)(vT + (16 * ct + fr) * 136 + 32 * ks + 8 * fq); acc[ct] = mfma16(vf, wf, acc[ct]); }
    }
    const int t = 16 * w + fr; const float bias = p.in[7][g * 128 + t]; const size_t tok = (size_t)(tok0 + t);
#pragma unroll
    for (int ct = 0; ct < 8; ++ct) {
        const u32x2 uu = *(const u32x2*)(WSB(O_PROJ) + tok * LDP + U_OFF + g * 128 + 16 * ct + 4 * fq);
        const float y0 = bf2f(uu.x & 0xffffu) * (acc[ct][0] + bias), y1 = bf2f(uu.x >> 16) * (acc[ct][1] + bias), y2 = bf2f(uu.y & 0xffffu) * (acc[ct][2] + bias), y3 = bf2f(uu.y >> 16) * (acc[ct][3] + bias);
        u32x2 o; o.x = cvt_pk_bf16(y0, y1); o.y = cvt_pk_bf16(y2, y3);
        *(u32x2*)(WSB(O_CAT) + tok * 2048 + g * 128 + 16 * ct + 4 * fq) = o;
    }
    __syncthreads();
}

DEV void compress_item(const Params& p, unsigned char* shm, int item) {
    const int tid = threadIdx.x, w = tid >> 6, lane = tid & 63, fr = lane & 15, fq = lane >> 4;
    const int kv = item >> 7, b = (item >> 6) & 1, g = (item >> 5) & 1, n0 = (item & 31) * 32;
    float* part = (float*)shm;
    bf16_t* hid = (bf16_t*)(shm + 131072);
    const bf16_t* W1 = kv ? WSB(O_W1V) : WSB(O_W1K);
    const bf16_t* W2 = kv ? WSB(O_W2V) : WSB(O_W2K);
    const int coff = (kv ? VC_OFF : KC_OFF) + g * 128;
    {
        f32x4 acc[2][8];
#pragma unroll
        for (int ns = 0; ns < 2; ++ns)
#pragma unroll
            for (int et = 0; et < 8; ++et) acc[ns][et] = (f32x4){0.f, 0.f, 0.f, 0.f};
        for (int ks = 0; ks < 16; ++ks) {
            const int l = 4 * w + (ks >> 2), d0 = 32 * (ks & 3) + 8 * fq;
            bf16x8 af[2];
#pragma unroll
            for (int ns = 0; ns < 2; ++ns) { const int nn = n0 + 16 * ns + fr; af[ns] = *(const bf16x8*)(WSB(O_PROJ) + (size_t)(b * S_ + 16 * nn + l) * LDP + coff + d0); }
#pragma unroll
            for (int et = 0; et < 8; ++et) { const bf16x8 wf = *(const bf16x8*)(W1 + (size_t)(16 * et + fr) * 4096 + 512 * w + 32 * ks + 8 * fq);
                acc[0][et] = mfma16(wf, af[0], acc[0][et]); acc[1][et] = mfma16(wf, af[1], acc[1][et]); }
        }
#pragma unroll
        for (int ns = 0; ns < 2; ++ns)
#pragma unroll
            for (int et = 0; et < 8; ++et) *(f32x4*)(part + (size_t)w * 4096 + (16 * ns + fr) * 128 + 16 * et + 4 * fq) = acc[ns][et];
    }
    __syncthreads();
#pragma unroll
    for (int i = 0; i < 8; ++i) { const int idx = tid + 512 * i, nn = idx >> 7, e = idx & 127; float s = 0.f;
#pragma unroll
        for (int j = 0; j < 8; ++j) s += WSF(O_CBIAS)[(kv * 8 + j) * 128 + e];
#pragma unroll
        for (int ww = 0; ww < 8; ++ww) s += part[ww * 4096 + idx];
        hid[nn * 136 + e] = (bf16_t)(cvt_pk_bf16(gelu_t(s), 0.f) & 0xffffu); }
    __syncthreads();
    {
        f32x4 acc[2];
        acc[0] = acc[1] = (f32x4){0.f, 0.f, 0.f, 0.f};
#pragma unroll
        for (int ks = 0; ks < 4; ++ks) {
            const bf16x8 wf = *(const bf16x8*)(W2 + (size_t)(16 * w + fr) * 128 + 32 * ks + 8 * fq);
#pragma unroll
            for (int ns = 0; ns < 2; ++ns) { const bf16x8 hf = *(const bf16x8*)(hid + (16 * ns + fr) * 136 + 32 * ks + 8 * fq);
                acc[ns] = kv ? mfma16(hf, wf, acc[ns]) : mfma16(wf, hf, acc[ns]); }
        }
        const int bg = b * 2 + g;
#pragma unroll
        for (int ns = 0; ns < 2; ++ns) {
            if (kv == 0) {
                const int nn = n0 + 16 * ns + fr; f32x4 v = acc[ns]; if (nn >= 1023) v = (f32x4){0.f, 0.f, 0.f, 0.f};
                u32x2 o; o.x = cvt_pk_bf16(v[0], v[1]); o.y = cvt_pk_bf16(v[2], v[3]);
                *(u32x2*)(WSB(O_KCMP) + ((size_t)bg * 1024 + nn) * 128 + 16 * w + 4 * fq) = o;
            } else {
                const int nb = n0 + 16 * ns + 4 * fq; f32x4 v = acc[ns]; if (nb + 3 >= 1023) v[3] = 0.f;
                u32x2 o; o.x = cvt_pk_bf16(v[0], v[1]); o.y = cvt_pk_bf16(v[2], v[3]);
                *(u32x2*)(WSB(O_VCMPT) + ((size_t)bg * 128 + 16 * w + fr) * 1024 + nb) = o;
            }
        }
    }
    __syncthreads();
}

constexpr int KB_BYTES = 16384, VB_BYTES = 16384;
constexpr int NQS = 1, QW = 16 * NQS, QI = 2 * QW;
constexpr int A_IMP = 0, IMP_STR = 260, A_MASK = A_IMP + QI * IMP_STR * 4, A_UNI = A_MASK + QI * 8 * 4;
constexpr int A_KB0 = (A_UNI + 32 + 4095) & ~4095, A_VB0 = A_KB0 + 16384, A_KB1 = A_KB0 + 32768, A_VB1 = A_KB0 + 49152;
static_assert(A_UNI + 32 <= 65536 && A_VB1 + 16384 <= LDS_BYTES, "lds");

DEV void tile_dma(unsigned char* shm, int kboff, int vboff, const char* kp, size_t kstr, const char* vp, size_t vstr, bool withV) {
    const int tid = threadIdx.x, wid = __builtin_amdgcn_readfirstlane(tid >> 6);
    LAS unsigned char* lds = (LAS unsigned char*)shm;
#pragma unroll
    for (int i = 0; i < 2; ++i) { const int P = tid * 16 + i * 8192, row = P >> 8, c = ((P >> 4) & 15) ^ (row & 15);
        __builtin_amdgcn_global_load_lds((const unsigned*)(kp + (size_t)row * kstr + c * 16), (LAS unsigned*)(lds + kboff + wid * 1024 + i * 8192), 16, 0, 0); }
    if (withV) {
#pragma unroll
        for (int i = 0; i < 2; ++i) { const int P = tid * 16 + i * 8192, row = P >> 7, c = ((P >> 4) & 7) ^ ((row >> 1) & 7);
            __builtin_amdgcn_global_load_lds((const unsigned*)(vp + (size_t)row * vstr + c * 16), (LAS unsigned*)(lds + vboff + wid * 1024 + i * 8192), 16, 0, 0); }
    }
}
DEV int next_bit(const unsigned* uni, int from) {
    for (int w = from >> 5; w < 8; ++w) { unsigned xw = uni[w]; if (w == (from >> 5)) xw &= (~0u) << (from & 31); if (xw) return w * 32 + __builtin_ctz(xw); }
    return -1;
}

struct AttnState { f32x4 O[NQS][8]; float m[NQS], l[NQS], invl[NQS]; };

template <int BR>
DEV void attn_tile(const unsigned char* kb, const unsigned char* vb, const bf16x8 (&qf)[NQS][4], AttnState& st, int tilebase,
                   const int (&tq)[NQS], const float (&ctq)[NQS], float slope2, const bool (&qsel)[NQS], unsigned* imp, int qrow, int fr, int fq) {
    f32x4 s[NQS][4];
#pragma unroll
    for (int kt = 0; kt < 4; ++kt) {
#pragma unroll
        for (int qs = 0; qs < NQS; ++qs) s[qs][kt] = (f32x4){0.f, 0.f, 0.f, 0.f};
#pragma unroll
        for (int ks = 0; ks < 4; ++ks) {
            const bf16x8 kf = *(const bf16x8*)(kb + (16 * kt + fr) * 256 + (((4 * ks + fq) ^ fr) << 4));
#pragma unroll
            for (int qs = 0; qs < NQS; ++qs) s[qs][kt] = mfma16(kf, qf[qs][ks], s[qs][kt]);
        }
    }
    constexpr float SC = 0.08838834764831845f * 1.4426950408889634f;
    constexpr bool CMP = (BR == 1 || BR == 2);
    constexpr float NINF = -__builtin_inff();
    const float sl = CMP ? 16.0f * slope2 : slope2;
#pragma unroll
    for (int qs = 0; qs < NQS; ++qs) {
        int lim = CMP ? (((tq[qs] - 31) >> 4) - tilebase - 4 * fq) : (tq[qs] - tilebase - 4 * fq);
        if (BR == 3) lim = qsel[qs] ? lim : -1;
        const int lo = lim - 512;
        const float lb = CMP ? fmaf(slope2, 16.0f * (float)(tilebase + 4 * fq) + 15.5f, ctq[qs]) : fmaf(slope2, (float)(tilebase + 4 * fq), ctq[qs]);
        float tmax = -1e30f;
#pragma unroll
        for (int kt = 0; kt < 4; ++kt)
#pragma unroll
            for (int j = 0; j < 4; ++j) {
                const int i = 16 * kt + j;
                bool valid = i <= lim;
                if (BR == 0) valid = valid && (i > lo);
                float xv = fmaf(s[qs][kt][j], SC, fmaf(sl, (float)i, lb));
                xv = valid ? xv : -1e30f;
                s[qs][kt][j] = xv; tmax = fmaxf(tmax, xv);
            }
        if (BR == 2) {
#pragma unroll
            for (int kt = 0; kt < 4; ++kt)
#pragma unroll
                for (int j = 0; j < 4; ++j) s[qs][kt][j] = fexp2(s[qs][kt][j] - st.m[qs]) * st.invl[qs];
        } else {
            tmax = fmaxf(tmax, __shfl_xor(tmax, 16)); tmax = fmaxf(tmax, __shfl_xor(tmax, 32));
            const float mnew = fmaxf(st.m[qs], tmax);
            const float alpha = fexp2(st.m[qs] - mnew);
            st.m[qs] = mnew;
            float ls = 0.f;
#pragma unroll
            for (int kt = 0; kt < 4; ++kt)
#pragma unroll
                for (int j = 0; j < 4; ++j) { const float xv = s[qs][kt][j]; const float pv = xv > -1e29f ? fexp2(xv - mnew) : 0.f; s[qs][kt][j] = pv; ls += pv; }
            st.l[qs] = st.l[qs] * alpha + ls;
            if (BR != 1) {
#pragma unroll
                for (int dt = 0; dt < 8; ++dt) st.O[qs][dt] *= alpha;
            }
        }
    }
    if (BR == 1) return;
#pragma unroll
    for (int s2 = 0; s2 < 2; ++s2) {
        bf16x8 pf[NQS];
#pragma unroll
        for (int qs = 0; qs < NQS; ++qs) {
            u32x4 pk; pk.x = cvt_pk_bf16(s[qs][2 * s2][0], s[qs][2 * s2][1]); pk.y = cvt_pk_bf16(s[qs][2 * s2][2], s[qs][2 * s2][3]);
            pk.z = cvt_pk_bf16(s[qs][2 * s2 + 1][0], s[qs][2 * s2 + 1][1]); pk.w = cvt_pk_bf16(s[qs][2 * s2 + 1][2], s[qs][2 * s2 + 1][3]);
            pf[qs] = __builtin_bit_cast(bf16x8, pk);
        }
#pragma unroll
        for (int dt = 0; dt < 8; ++dt) {
            const unsigned char* vrow = vb + (16 * dt + fr) * 128 + (fq & 1) * 8;
            const int c0 = 4 * s2 + (fq >> 1), sw = (fr >> 1) & 7;
            const u32x2 lo = *(const u32x2*)(vrow + ((c0 ^ sw) << 4)), hi = *(const u32x2*)(vrow + (((c0 + 2) ^ sw) << 4));
            u32x4 vv; vv.x = lo.x; vv.y = lo.y; vv.z = hi.x; vv.w = hi.y;
            const bf16x8 vf = __builtin_bit_cast(bf16x8, vv);

#pragma unroll
            for (int qs = 0; qs < NQS; ++qs) st.O[qs][dt] = mfma16(vf, pf[qs], st.O[qs][dt]);
        }
    }
    if (BR == 2) {
#pragma unroll
        for (int qs = 0; qs < NQS; ++qs) {
            unsigned* ip = imp + (qrow + 16 * qs) * IMP_STR + (tilebase >> 2) + fq;
#pragma unroll
            for (int kt = 0; kt < 4; ++kt) {
                const float p0 = s[qs][kt][0], p1 = s[qs][kt][1], p2 = s[qs][kt][2], p3 = s[qs][kt][3];
                const unsigned ua = (unsigned)(fmaf(2.0f, p0 + p1 + p2, p3) * 268435456.0f + 0.5f), uc = (unsigned)(p3 * 268435456.0f + 0.5f);
                const int J = (tilebase >> 2) + 4 * kt + fq;
                atomicAdd(ip + 4 * kt, ua);
                atomicAdd(ip + 4 * kt + (J + 1 < 256 ? 1 : 0), J + 1 < 256 ? uc : 0u);
            }
        }
    }
}

struct AttnItem { int b, g, t0; };

template <int BR>
DEV void attn_branch(const Params& p, unsigned char* shm, const AttnItem it, const bf16x8 (&qf)[NQS][4], AttnState& st,
                     const int (&tq)[NQS], const float (&ctq)[NQS], float slope2, int first_or_cnt) {
    const int tid = threadIdx.x, lane = tid & 63, fr = lane & 15, fq = lane >> 4, w = tid >> 6, wq = w & 1;
    const unsigned* uni = (const unsigned*)(shm + A_UNI);
    const unsigned* mask = (const unsigned*)(shm + A_MASK);
    unsigned* imp = (unsigned*)(shm + A_IMP);
    const bool withV = (BR != 1);
    const int bg = it.b * 2 + it.g;
    const int qrow = wq * QW + fr;
    int cur;
    if (BR == 0) cur = first_or_cnt; else if (BR == 3) cur = next_bit(uni, 0); else cur = 0;
    auto nexttile = [&](int c) -> int {
        if (BR == 0) return c + 1 <= 8 ? c + 1 : -1;
        if (BR == 3) return next_bit(uni, c + 1);
        return c + 1 < first_or_cnt ? c + 1 : -1;
    };
    auto tbase = [&](int c) -> int { return BR == 0 ? (it.t0 & ~63) - 512 + 64 * c : 64 * c; };
    auto kptr = [&](int c) -> const char* {
        if (BR == 0) return (const char*)(WSB(O_PROJ) + (size_t)(it.b * S_ + tbase(c)) * LDP + KW_OFF + it.g * 128);
        if (BR == 3) return (const char*)(WSB(O_PROJ) + (size_t)(it.b * S_ + tbase(c)) * LDP + KS_OFF + it.g * 128);
        return (const char*)(WSB(O_KCMP) + ((size_t)bg * 1024 + tbase(c)) * 128);
    };
    auto vptr = [&](int c) -> const char* {
        if (BR == 0) return (const char*)(WSB(O_VT) + (size_t)(256 + it.g * 128) * T_ + it.b * S_ + tbase(c));
        if (BR == 3) return (const char*)(WSB(O_VT) + (size_t)(it.g * 128) * T_ + it.b * S_ + tbase(c));
        return (const char*)(WSB(O_VCMPT) + (size_t)bg * 128 * 1024 + tbase(c));
    };
    const size_t kstr = (BR == 0 || BR == 3) ? (size_t)LDP * 2 : 256, vstr = (BR == 0 || BR == 3) ? (size_t)T_ * 2 : 2048;
    if (cur < 0) return;
    tile_dma(shm, A_KB0, A_VB0, kptr(cur), kstr, vptr(cur), vstr, withV);
    asm volatile("s_waitcnt vmcnt(0)" ::: "memory");
    __syncthreads();
    int buf = 0;
    while (cur >= 0) {
        const int nxt = nexttile(cur);
        if (nxt >= 0) tile_dma(shm, buf ? A_KB0 : A_KB1, buf ? A_VB0 : A_VB1, kptr(nxt), kstr, vptr(nxt), vstr, withV);
        bool qsel[NQS]; bool anysel = false;
#pragma unroll
        for (int qs = 0; qs < NQS; ++qs) qsel[qs] = true;
        bool run = true;
        if (BR == 3) {
#pragma unroll
            for (int qs = 0; qs < NQS; ++qs) { qsel[qs] = (mask[(qrow + 16 * qs) * 8 + (cur >> 5)] >> (cur & 31)) & 1u; anysel = anysel | qsel[qs]; }
            run = __any((int)anysel) != 0;
        }
        if (run) attn_tile<BR>(shm + (buf ? A_KB1 : A_KB0), shm + (buf ? A_VB1 : A_VB0), qf, st, tbase(cur), tq, ctq, slope2, qsel, imp, qrow, fr, fq);
        asm volatile("s_waitcnt vmcnt(0)" ::: "memory");
        __syncthreads();
        cur = nxt; buf ^= 1;
    }
}

template <int MODE>
DEV void attn_store(const Params& p, const AttnItem it, const AttnState& st, const float (&scl)[NQS], int h, int wq, int fr, int fq) {
#pragma unroll
    for (int qs = 0; qs < NQS; ++qs) {
        const size_t tok = (size_t)(it.b * S_ + it.t0 + wq * QW + 16 * qs + fr);
        float* yp = WSF(O_YPART) + tok * 1024 + h * 128 + 4 * fq;
#pragma unroll
        for (int dt = 0; dt < 8; ++dt) {
            f32x4 v = st.O[qs][dt] * scl[qs];
            if (MODE == 3) { u32x2 w3; w3.x = cvt_pk_bf16(v[0], v[1]); w3.y = cvt_pk_bf16(v[2], v[3]); *(u32x2*)(WSB(O_CAT) + tok * 2048 + 1024 + h * 128 + 16 * dt + 4 * fq) = w3; }
            else if (MODE == 0) *(f32x4*)(yp + 16 * dt) = v;
            else if (MODE == 1) { const f32x4 o = *(const f32x4*)(yp + 16 * dt); *(f32x4*)(yp + 16 * dt) = o + v; }
            else { const f32x4 o = *(const f32x4*)(yp + 16 * dt); v += o; u32x2 w2; w2.x = cvt_pk_bf16(v[0], v[1]); w2.y = cvt_pk_bf16(v[2], v[3]);
                *(u32x2*)(WSB(O_CAT) + tok * 2048 + 1024 + h * 128 + 16 * dt + 4 * fq) = w2; }
        }
    }
}

DEV void attn_setup(const Params& p, const AttnItem it, bf16x8 (&qf)[NQS][4], int (&tq)[NQS], float (&ctq)[NQS], float& slope2, int& h, int& wq, int fr, int fq) {
    const int w = threadIdx.x >> 6; wq = w & 1; const int r = w >> 1; h = it.g * 4 + r;
    slope2 = fexp2(-(float)(h + 1)) * 1.4426950408889634f;
#pragma unroll
    for (int qs = 0; qs < NQS; ++qs) {
        tq[qs] = it.t0 + wq * QW + 16 * qs + fr; ctq[qs] = -slope2 * (float)tq[qs];
        const bf16_t* qp = WSB(O_PROJ) + (size_t)(it.b * S_ + tq[qs]) * LDP + Q_OFF + h * 128 + 8 * fq;
#pragma unroll
        for (int ks = 0; ks < 4; ++ks) qf[qs][ks] = *(const bf16x8*)(qp + 32 * ks);
    }
}
DEV void attn_reset(AttnState& st) {
#pragma unroll
    for (int qs = 0; qs < NQS; ++qs) { st.m[qs] = -1e30f; st.l[qs] = 0.f; st.invl[qs] = 0.f;
#pragma unroll
        for (int dt = 0; dt < 8; ++dt) st.O[qs][dt] = (f32x4){0.f, 0.f, 0.f, 0.f}; }
}
DEV float gate_of(const Params& p, const AttnItem it, int tqv, int h, int br) { return sigmoid_f(bf2f(WSB(O_PROJ)[(size_t)(it.b * S_ + tqv) * LDP + GT_OFF + h * 3 + br])); }
DEV void attn_finish_l(AttnState& st) {
#pragma unroll
    for (int qs = 0; qs < NQS; ++qs) { float lt = st.l[qs]; lt += __shfl_xor(lt, 16); lt += __shfl_xor(lt, 32); st.invl[qs] = lt > 0.f ? 1.0f / lt : 0.f; }
}

DEV void window_item(const Params& p, unsigned char* shm, int item) {
    const int lane = threadIdx.x & 63, fr = lane & 15, fq = lane >> 4;
    constexpr int NQT = S_ / QI;
    AttnItem it; it.b = item / (2 * NQT); it.g = (item / NQT) & 1; const int qt = item % NQT; it.t0 = qt * QI;
    bf16x8 qf[NQS][4]; int tq[NQS]; float ctq[NQS]; float slope2; int h, wq;
    attn_setup(p, it, qf, tq, ctq, slope2, h, wq, fr, fq);
    AttnState st; attn_reset(st);
    attn_branch<0>(p, shm, it, qf, st, tq, ctq, slope2, (it.t0 >> 6) >= 8 ? 0 : 8 - (it.t0 >> 6));
    attn_finish_l(st);
    float scl[NQS];
#pragma unroll
    for (int qs = 0; qs < NQS; ++qs) scl[qs] = st.invl[qs] * gate_of(p, it, tq[qs], h, 2);
    attn_store<0>(p, it, st, scl, h, wq, fr, fq);
}

DEV void cmpsel_item(const Params& p, unsigned char* shm, int item) {
    const int tid = threadIdx.x, lane = tid & 63, fr = lane & 15, fq = lane >> 4, w = tid >> 6;
    constexpr int NQT = S_ / QI;
    AttnItem it; const int combo = item & 3, qt = NQT - 1 - (item >> 2); it.b = combo >> 1; it.g = combo & 1; it.t0 = qt * QI;
    unsigned* imp = (unsigned*)(shm + A_IMP); unsigned* mask = (unsigned*)(shm + A_MASK); unsigned* uni = (unsigned*)(shm + A_UNI);
    for (int i = tid; i < QI * IMP_STR; i += 512) imp[i] = 0u;
    if (tid < 8) uni[tid] = 0u;
    bf16x8 qf[NQS][4]; int tq[NQS]; float ctq[NQS]; float slope2; int h, wq;
    attn_setup(p, it, qf, tq, ctq, slope2, h, wq, fr, fq);
    AttnState st; attn_reset(st);
    int cnt = (it.t0 + QI - 32) / 16 + 1; if (cnt > 1024) cnt = 1024; const int ntile = (cnt + 63) >> 6;
#ifndef PROBE_NO_CMP
    attn_branch<1>(p, shm, it, qf, st, tq, ctq, slope2, ntile);
    attn_finish_l(st);
    attn_branch<2>(p, shm, it, qf, st, tq, ctq, slope2, ntile);
#endif
    f32x4 Oc[NQS][8];
#pragma unroll
    for (int qs = 0; qs < NQS; ++qs) { const float gc = gate_of(p, it, tq[qs], h, 0);
#pragma unroll
        for (int dt = 0; dt < 8; ++dt) Oc[qs][dt] = st.O[qs][dt] * gc; }
    {
        constexpr int NQW = QI / 8;
        unsigned val[NQW][4]; bool cz[NQW][4]; unsigned thr[NQW];
#pragma unroll
        for (int qi = 0; qi < NQW; ++qi) {
            const int q = w * NQW + qi, t = it.t0 + q, cur = t >> 6;
            const u32x4 v = *(const u32x4*)(imp + q * IMP_STR + 4 * lane);
            thr[qi] = 0u;
#pragma unroll
            for (int i = 0; i < 4; ++i) { const int J = 4 * lane + i; const bool forced = (J == 0) | (J == cur) | (J == cur - 1);
                val[qi][i] = forced ? 0xFFFFFFFFu : v[i]; cz[qi][i] = J <= cur; }
        }
        for (int bit = 31; bit >= 0; --bit) {
#pragma unroll
            for (int qi = 0; qi < NQW; ++qi) {
                const unsigned cand = thr[qi] | (1u << bit); int cnt = 0;
#pragma unroll
                for (int i = 0; i < 4; ++i) cnt += __popcll(__ballot(cz[qi][i] && val[qi][i] >= cand));
                thr[qi] = cnt >= 16 ? cand : thr[qi];
            }
        }
#pragma unroll
        for (int qi = 0; qi < NQW; ++qi) {
            int cgt = 0; unsigned long long be[4]; bool gt[4], eq[4];
#pragma unroll
            for (int i = 0; i < 4; ++i) { gt[i] = cz[qi][i] && val[qi][i] > thr[qi]; eq[i] = cz[qi][i] && val[qi][i] == thr[qi]; cgt += __popcll(__ballot(gt[i])); be[i] = __ballot(eq[i]); }
            const int r = 16 - cgt;
            int rank = 0;
#pragma unroll
            for (int i = 0; i < 4; ++i) rank += (int)__builtin_amdgcn_mbcnt_hi((unsigned)(be[i] >> 32), __builtin_amdgcn_mbcnt_lo((unsigned)be[i], 0u));
            unsigned nib = 0u;
#pragma unroll
            for (int i = 0; i < 4; ++i) { const bool sel = gt[i] || (eq[i] && rank < r); nib |= sel ? (1u << i) : 0u; rank += eq[i] ? 1 : 0; }
            unsigned x = nib << (4 * (lane & 7));
            x |= __shfl_xor(x, 1); x |= __shfl_xor(x, 2); x |= __shfl_xor(x, 4);
            mask[(w * NQW + qi) * 8 + (lane >> 3)] = x;
        }
    }
    __syncthreads();
    if (tid < QI * 8) atomicOr(uni + (tid & 7), mask[tid]);
    __syncthreads();
    attn_reset(st);
    attn_branch<3>(p, shm, it, qf, st, tq, ctq, slope2, 0);
    attn_finish_l(st);
    {
#pragma unroll
        for (int qs = 0; qs < NQS; ++qs) { const float gs = st.invl[qs] * gate_of(p, it, tq[qs], h, 1);
#pragma unroll
            for (int dt = 0; dt < 8; ++dt) Oc[qs][dt] = st.O[qs][dt] * gs + Oc[qs][dt]; }
        attn_reset(st);
        attn_branch<0>(p, shm, it, qf, st, tq, ctq, slope2, (it.t0 >> 6) >= 8 ? 0 : 8 - (it.t0 >> 6));
        attn_finish_l(st);
        float scl[NQS];
#pragma unroll
        for (int qs = 0; qs < NQS; ++qs) { const float gw = st.invl[qs] * gate_of(p, it, tq[qs], h, 2); scl[qs] = 1.0f;
#pragma unroll
            for (int dt = 0; dt < 8; ++dt) st.O[qs][dt] = st.O[qs][dt] * gw + Oc[qs][dt]; }
        attn_store<3>(p, it, st, scl, h, wq, fr, fq);
    }
    __syncthreads();
}

DEV void phase_conv(const Params& p) {
    const size_t nvec = (size_t)T_ * DM / 8;
    for (size_t i = (size_t)blockIdx.x * 512 + threadIdx.x; i < nvec; i += (size_t)gridDim.x * 512) {
        const size_t tok = i >> 8; const int c0 = (int)(i & 255) * 8; const int s = (int)(tok & (S_ - 1));
        const u32x4 z2 = *(const u32x4*)(WSB(O_ZZ) + tok * DM + c0);
        u32x4 z1 = (u32x4){0u, 0u, 0u, 0u}, z0 = (u32x4){0u, 0u, 0u, 0u};
        if (s >= 1) z1 = *(const u32x4*)(WSB(O_ZZ) + (tok - 1) * DM + c0);
        if (s >= 2) z0 = *(const u32x4*)(WSB(O_ZZ) + (tok - 2) * DM + c0);
        const u32x4 bgv = *(const u32x4*)(WSB(O_BG) + tok * DM + c0);
        float r[8];
#pragma unroll
        for (int e = 0; e < 8; ++e) {
            const int c = c0 + e; const unsigned sh = (e & 1) ? 16u : 0u;
            const float a0 = bf2f((z0[e >> 1] >> sh) & 0xffffu), a1 = bf2f((z1[e >> 1] >> sh) & 0xffffu), a2 = bf2f((z2[e >> 1] >> sh) & 0xffffu), bb = bf2f((bgv[e >> 1] >> sh) & 0xffffu);
            r[e] = bb * (p.in[16][c] * a0 + p.in[16][DM + c] * a1 + p.in[16][2 * DM + c] * a2);
        }
        u32x4 o; o.x = cvt_pk_bf16(r[0], r[1]); o.y = cvt_pk_bf16(r[2], r[3]); o.z = cvt_pk_bf16(r[4], r[5]); o.w = cvt_pk_bf16(r[6], r[7]);
        *(u32x4*)(WSB(O_MIX) + tok * DM + c0) = o;
    }
}

DEV void grid_barrier(unsigned* ctr, unsigned& nbar) {
    asm volatile("s_waitcnt vmcnt(0) lgkmcnt(0)" ::: "memory");
    __syncthreads();
    if (threadIdx.x == 0) {
        __builtin_amdgcn_fence(__ATOMIC_RELEASE, "agent");
        asm volatile("s_waitcnt vmcnt(0)" ::: "memory");
        __hip_atomic_fetch_add(ctr, 1u, __ATOMIC_RELAXED, __HIP_MEMORY_SCOPE_AGENT);
        const unsigned target = (nbar + 1u) * gridDim.x;
        while (__hip_atomic_load(ctr, __ATOMIC_RELAXED, __HIP_MEMORY_SCOPE_AGENT) < target) __builtin_amdgcn_s_sleep(1);
        __builtin_amdgcn_fence(__ATOMIC_ACQUIRE, "agent");
        asm volatile("s_waitcnt vmcnt(0)" ::: "memory");
    }
    __syncthreads();
    ++nbar;
}

__global__ void __launch_bounds__(512, 2) mega(Params p, int ph_lo, int ph_hi, int coop) {
    extern __shared__ __attribute__((aligned(16))) unsigned char shm[];
    cg::grid_group grid = cg::this_grid();
#ifdef DIAG_MASK
    unsigned long long tprev_ = __builtin_amdgcn_s_memrealtime(); float accms_ = 0.f;
#define DIAG_TICK(n) { const unsigned long long now_ = __builtin_amdgcn_s_memrealtime(); if (((DIAG_MASK) >> (n)) & 1) accms_ += (float)(now_ - tprev_) * 1e-5f; tprev_ = now_; }
#else
#define DIAG_TICK(n)
#endif
#define PH_BEGIN(n) if (ph_lo <= (n) && (n) < ph_hi) {
#define PH_END(n) } if (coop && ph_lo <= (n) && (n) + 1 < ph_hi) { \
        if ((n) == 0) { asm volatile("s_waitcnt vmcnt(0) lgkmcnt(0)" ::: "memory"); grid.sync(); __builtin_amdgcn_fence(__ATOMIC_ACQUIRE, "agent"); asm volatile("s_waitcnt vmcnt(0)" ::: "memory"); } \
        else grid_barrier(bar_, nbar_); \
        DIAG_TICK(n) }
    unsigned* bar_ = (unsigned*)(p.ws + WS_END); unsigned nbar_ = 0u;
    PH_BEGIN(0) phase_prep(p, shm); PH_END(0)
    PH_BEGIN(1)
        pg8::EpiBf16Act e1; e1.O = WSB(O_PROJ); e1.ldc = LDP; e1.gelu_tiles = 8;
        run_gemm(shm, WSB(O_HN), WSB(O_WIN), T_, LDP, DM, e1);
        pg8::EpiBf16Act e2; e2.O = WSB(O_VT); e2.ldc = T_; e2.gelu_tiles = 0;
        run_gemm(shm, WSB(O_WV), WSB(O_HN), 512, T_, DM, e2);
    PH_END(1)
    PH_BEGIN(2)
        for (int it = blockIdx.x; it < 256; it += gridDim.x) compress_item(p, shm, it);
    PH_END(2)
    PH_BEGIN(3)
        unsigned* qctr = (unsigned*)(p.ws + WS_END) + 16; int* qslot = (int*)(shm + A_UNI + 32);
        for (;;) {
            if (threadIdx.x == 0) *qslot = (int)__hip_atomic_fetch_add(qctr, 1u, __ATOMIC_RELAXED, __HIP_MEMORY_SCOPE_AGENT);
            __syncthreads();
            const int item = *qslot;
            __syncthreads();
            if (item >= 4 * (S_ / QI) + 2048) break;
            if (item < 4 * (S_ / QI)) cmpsel_item(p, shm, item); else sgu_item(p, shm, item - 4 * (S_ / QI));
        }
    PH_END(3)
    PH_BEGIN(4) pg8::EpiResidB e; e.C = WSB(O_HRES); e.Rf = p.in[0]; e.Rb = nullptr; e.ldc = DM; run_gemm(shm, WSB(O_CAT), WSB(O_WOUT), T_, DM, DM, e); PH_END(4)
    PH_BEGIN(5) rmsnorm_rows<true>(WSB(O_HRES), p.in[2], WSB(O_HN), nullptr); PH_END(5)
    PH_BEGIN(6) pg8::EpiPair e; e.O = WSB(O_ACT); e.ldc = DFF; e.mode = 0; e.O0 = nullptr; e.ldc0 = 0; e.plain_tiles = 0; run_gemm(shm, WSB(O_HN), WSB(O_WGU0), T_, 2 * DFF, DM, e); PH_END(6)
    PH_BEGIN(7) pg8::EpiResidB e; e.C = WSB(O_HRES); e.Rf = nullptr; e.Rb = WSB(O_HRES); e.ldc = DM; run_gemm(shm, WSB(O_ACT), WSB(O_WDN0), T_, DM, DFF, e); PH_END(7)
    PH_BEGIN(8) rmsnorm_rows<true>(WSB(O_HRES), p.in[1] + DM, WSB(O_HN), nullptr); PH_END(8)
    PH_BEGIN(9) pg8::EpiPair e; e.O = WSB(O_ZZ); e.ldc = DM; e.mode = 1; e.O0 = WSB(O_BG); e.ldc0 = DM; e.plain_tiles = 8; run_gemm(shm, WSB(O_HN), WSB(O_WINC), T_, 6144, DM, e); PH_END(9)
    PH_BEGIN(10) phase_conv(p); PH_END(10)
    PH_BEGIN(11) pg8::EpiResidB e; e.C = WSB(O_HRES); e.Rf = nullptr; e.Rb = WSB(O_HRES); e.ldc = DM; run_gemm(shm, WSB(O_MIX), WSB(O_WOUTC), T_, DM, DM, e); PH_END(11)
    PH_BEGIN(12) rmsnorm_rows<true>(WSB(O_HRES), p.in[2] + DM, WSB(O_HN), nullptr); PH_END(12)
    PH_BEGIN(13) pg8::EpiPair e; e.O = WSB(O_ACT); e.ldc = DFF; e.mode = 0; e.O0 = nullptr; e.ldc0 = 0; e.plain_tiles = 0; run_gemm(shm, WSB(O_HN), WSB(O_WGU1), T_, 2 * DFF, DM, e); PH_END(13)
    PH_BEGIN(14) pg8::EpiResidB e; e.C = WSB(O_HRES); e.Rf = nullptr; e.Rb = WSB(O_HRES); e.ldc = DM; run_gemm(shm, WSB(O_ACT), WSB(O_WDN1), T_, DM, DFF, e); PH_END(14)
    PH_BEGIN(15) rmsnorm_rows<true>(WSB(O_HRES), p.in[3], nullptr, p.out); PH_END(15)
#ifdef DIAG_MASK
    if (blockIdx.x == 0 && threadIdx.x == 0) p.out[0] += accms_;
#endif
#ifdef DUMP_OFF
    if (ph_hi < 16) { __builtin_amdgcn_fence(__ATOMIC_RELEASE, "agent"); grid.sync(); __builtin_amdgcn_fence(__ATOMIC_ACQUIRE, "agent");
        const size_t half = (size_t)T_ * 1024;
        for (size_t i = (size_t)blockIdx.x * 512 + threadIdx.x; i < 2 * half; i += (size_t)gridDim.x * 512) {
            float v;
            v = bf2f(WSB(O_CAT)[i]);
            p.out[i] = v; } }
#endif
}
constexpr int NPHASE = 16;

extern "C" void kernel_launch(void* const* d_in, const int* in_sizes, int n_in, void* d_out, int out_size, void* d_ws, size_t ws_size, hipStream_t stream) {
    static int grid_blocks = 0;
    if (!grid_blocks) {
        int dev = 0, cus = 0, per_cu = 0;
        hipGetDevice(&dev);
        hipDeviceGetAttribute(&cus, hipDeviceAttributeMultiprocessorCount, dev);
        hipFuncSetAttribute((const void*)mega, hipFuncAttributeMaxDynamicSharedMemorySize, LDS_BYTES);
        hipOccupancyMaxActiveBlocksPerMultiprocessor(&per_cu, (const void*)mega, 512, LDS_BYTES);
        if (per_cu < 1) { fprintf(stderr, "occupancy query returned %d\n", per_cu); per_cu = 1; }
        grid_blocks = cus * per_cu;
        (void)hipGetLastError();
    }
    Params p{};
    for (int i = 0; i < 21; ++i) p.in[i] = (const float*)d_in[i];
    p.out = (float*)d_out; p.ws = (unsigned char*)d_ws;
    if (WS_NEED > ws_size || n_in != 21) { fprintf(stderr, "workspace too small / bad inputs: need %zu have %zu, n_in %d\n", (size_t)WS_END, ws_size, n_in); return; }
    #ifdef DUMP_HI
    int lo = 0, hi = DUMP_HI, coop = 1;
#else
    int lo = 0, hi = NPHASE, coop = 1;
#endif
    (void)hipMemsetAsync((unsigned char*)d_ws + WS_END, 0, 256, stream);
    void* args[] = {&p, &lo, &hi, &coop};
    hipError_t e = hipLaunchCooperativeKernel((const void*)mega, dim3(grid_blocks), dim3(512), args, LDS_BYTES, stream);
    if (e != hipSuccess) fprintf(stderr, "cooperative launch failed: %s (grid %d)\n", hipGetErrorString(e), grid_blocks);
}
```

```cpp
#include <hip/hip_runtime.h>
#include <hip/hip_cooperative_groups.h>
#include <cstdio>
namespace cg = cooperative_groups;

#define DEV __device__ __forceinline__
#define LAS __attribute__((address_space(3)))
typedef unsigned short bf16_t;
typedef short bf16x8 __attribute__((ext_vector_type(8)));
typedef float f32x4 __attribute__((ext_vector_type(4)));
typedef float f32x2 __attribute__((ext_vector_type(2)));
typedef unsigned u32x4 __attribute__((ext_vector_type(4)));
typedef unsigned u32x2 __attribute__((ext_vector_type(2)));

constexpr int S_ = 16384, T_ = 32768, DM = 2048, DFF = 5632;
constexpr int LDP = 4352;
constexpr int U_OFF = 0, V_OFF = 1024, Q_OFF = 2048, KC_OFF = 3072, VC_OFF = 3328, KS_OFF = 3584, KW_OFF = 3840, GT_OFF = 4096;
constexpr int LDS_BYTES = 141312;
constexpr float EPS = 1e-6f;

struct Params { const float* in[21]; float* out; unsigned char* ws; };
constexpr size_t al256(size_t x) { return (x + 255) & ~(size_t)255; }
constexpr size_t O_WIN = 0;
constexpr size_t O_WV = O_WIN + al256((size_t)LDP * DM * 2);
constexpr size_t O_WOUT = O_WV + al256((size_t)512 * DM * 2);
constexpr size_t O_WGU0 = O_WOUT + al256((size_t)DM * DM * 2);
constexpr size_t O_WGU1 = O_WGU0 + al256((size_t)2 * DFF * DM * 2);
constexpr size_t O_WDN0 = O_WGU1 + al256((size_t)2 * DFF * DM * 2);
constexpr size_t O_WDN1 = O_WDN0 + al256((size_t)DM * DFF * 2);
constexpr size_t O_WINC = O_WDN1 + al256((size_t)DM * DFF * 2);
constexpr size_t O_WOUTC = O_WINC + al256((size_t)6144 * DM * 2);
constexpr size_t O_W1K = O_WOUTC + al256((size_t)DM * DM * 2);
constexpr size_t O_W1V = O_W1K + al256((size_t)128 * 4096 * 2);
constexpr size_t O_W2K = O_W1V + al256((size_t)128 * 4096 * 2);
constexpr size_t O_W2V = O_W2K + al256(128 * 128 * 2);
constexpr size_t O_SGUW = O_W2V + al256(128 * 128 * 2);
constexpr size_t O_CBIAS = O_SGUW + al256(8 * 128 * 128 * 2);
constexpr size_t O_KCMP = O_CBIAS + 8192;
constexpr size_t O_VCMPT = O_KCMP + al256((size_t)4 * 1024 * 128 * 2);
constexpr size_t O_HN = O_VCMPT + al256((size_t)4 * 128 * 1024 * 2);
constexpr size_t O_BIG = O_HN + al256((size_t)T_ * DM * 2);
constexpr size_t O_PROJ = O_BIG;
constexpr size_t O_VT = O_PROJ + al256((size_t)(T_ + 32) * LDP * 2);
constexpr size_t O_CAT = O_VT + al256((size_t)512 * T_ * 2);
constexpr size_t O_YPART = O_CAT + al256((size_t)T_ * DM * 2);
constexpr size_t WS_END = O_YPART + al256((size_t)T_ * 1024 * 4);
constexpr size_t O_ACT = O_BIG;
constexpr size_t O_BG = O_BIG;
constexpr size_t O_ZZ = O_BG + al256((size_t)T_ * DM * 2);
constexpr size_t O_MIX = O_ZZ + al256((size_t)T_ * DM * 2);
static_assert(O_ACT + (size_t)T_ * DFF * 2 <= WS_END && O_MIX + (size_t)T_ * DM * 2 <= WS_END, "ws alias");
constexpr size_t O_HRES = O_YPART;
constexpr size_t WS_NEED = WS_END + 256;
#define WSB(off) ((bf16_t*)(p.ws + (off)))
#define WSF(off) ((float*)(p.ws + (off)))

DEV float bf2f(unsigned h) { return __uint_as_float(h << 16); }
DEV unsigned cvt_pk_bf16(float lo, float hi) { unsigned r; asm("v_cvt_pk_bf16_f32 %0, %1, %2" : "=v"(r) : "v"(lo), "v"(hi)); return r; }
DEV float fexp2(float x) { return __builtin_amdgcn_exp2f(x); }
DEV float frcp(float x) { return __builtin_amdgcn_rcpf(x); }
DEV float gelu_t(float x) { const float u = x * (1.0f + 0.044715f * x * x); return x * frcp(1.0f + fexp2(-2.3022082f * u)); }
DEV float silu_f(float x) { return x * frcp(1.0f + fexp2(-1.4426950409f * x)); }
DEV float sigmoid_f(float x) { return frcp(1.0f + fexp2(-1.4426950409f * x)); }
DEV f32x4 mfma16(bf16x8 a, bf16x8 b, f32x4 c) { return __builtin_amdgcn_mfma_f32_16x16x32_bf16(a, b, c, 0, 0, 0); }

namespace pg8 {
constexpr int BM = 256, BK = 64, HALF = 128, HTB = HALF * BK * 2, STAGE_BYTES = 8 * HTB, NXCD = 8, WGM = 4;
DEV int lds_byte(int r, int c) { const int st = (r >> 4) * 2 + (c >> 5), rr = r & 15, cc = c & 31, ob = rr * 64 + cc * 2; return st * 1024 + (ob ^ (((ob >> 9) & 1) << 5)); }
DEV void stage_rc(int b, int& R, int& C) { const int st = b / 1024, sb = b % 1024, swz = sb ^ (((sb >> 9) & 1) << 5); R = (st >> 1) * 16 + swz / 64; C = (st & 1) * 32 + (swz % 64) / 2; }
DEV int perm32(int rho) { const int n = rho >> 4, i = rho & 15; return 8 * (i >> 2) + 4 * n + (i & 3); }
struct Unit { int pm, pn; };
struct Gemm { const bf16_t* A; const bf16_t* Bt; int M, N, K; };
struct StaticOrder {
    int nM, nN, nwg, G, c;
    DEV void init(int M, int N, int G_, int c_) { nM = M / BM; nN = N / BM; nwg = nM * nN; G = G_; c = c_; }
    DEV bool next(int i, Unit& u) const {
        const long L = (long)i * G + c; if (L >= nwg) return false;
        int wgid = (int)L; { const int q = nwg / NXCD, r = nwg % NXCD, xcd = wgid % NXCD, off = wgid / NXCD; wgid = (xcd < r ? xcd * (q + 1) : r * (q + 1) + (xcd - r) * q) + off; }
        const int nig = WGM * nN, gid = wgid / nig, fm = gid * WGM, gsz = (nM - fm) < WGM ? (nM - fm) : WGM;
        u.pm = fm + ((wgid % nig) % gsz); u.pn = (wgid % nig) / gsz; return true;
    }
};

template <class Epi>
DEV void gemm_phase(LAS unsigned char* lds, const Gemm g, const StaticOrder& S, const Epi& E) {
    const int tid = threadIdx.x, wid = __builtin_amdgcn_readfirstlane(tid >> 6), lane = tid & 63, wr = wid >> 2, wc = wid & 3, fr = lane & 15, fq = lane >> 4;
    const int K = g.K, nt = K / BK;
    unsigned voffA[2], voffB[2];
#pragma unroll
    for (int i = 0; i < 2; ++i) { int R, C; stage_rc(tid * 16 + i * 8192, R, C); const int Rb = Epi::PERM ? ((R & ~31) + perm32(R & 31)) : R;
        voffA[i] = (unsigned)(R * K + C) * 2u; voffB[i] = (unsigned)(Rb * K + C) * 2u; }
    const size_t kstep = (size_t)(BK * 2);
    const size_t hstep = (size_t)HALF * K * 2;
    const size_t tstep = 2 * hstep;
    const unsigned ldsw = (unsigned)wid * 1024u;
    const int aoff = lds_byte(wr * 64 + fr, fq * 8), boff = lds_byte(wc * 32 + fr, fq * 8);
#define PG8_SA(b, h) (((b) * 2 + (h)) * HTB)
#define PG8_SB(b, h) ((4 + (b) * 2 + (h)) * HTB)
#define PG8_STAGE(bufoff, gbase, voff) do { _Pragma("unroll") for (int _i = 0; _i < 2; ++_i) \
        __builtin_amdgcn_global_load_lds((const unsigned*)((const char*)(gbase) + (voff)[_i]), (LAS unsigned*)(lds + (bufoff) + ldsw + _i * 8192), 16, 0, 0); } while (0)
#define PG8_LDA(dst, b, h) do { _Pragma("unroll") for (int m = 0; m < 4; ++m) _Pragma("unroll") for (int k = 0; k < 2; ++k) dst[m][k] = *(const LAS bf16x8*)(lds + PG8_SA(b, h) + aoff + m * 2048 + k * 1024); } while (0)
#define PG8_LDB(dst, b, h) do { _Pragma("unroll") for (int n = 0; n < 2; ++n) _Pragma("unroll") for (int k = 0; k < 2; ++k) dst[n][k] = *(const LAS bf16x8*)(lds + PG8_SB(b, h) + boff + n * 2048 + k * 1024); } while (0)
#define PG8_MMA(ai, bj, At, Bt) do { __builtin_amdgcn_s_setprio(1); _Pragma("unroll") for (int m = 0; m < 4; ++m) _Pragma("unroll") for (int n = 0; n < 2; ++n) _Pragma("unroll") for (int k = 0; k < 2; ++k) \
        acc[ai][bj][m][n] = __builtin_amdgcn_mfma_f32_16x16x32_bf16(Bt[n][k], At[m][k], acc[ai][bj][m][n], 0, 0, 0); __builtin_amdgcn_s_setprio(0); } while (0)
#define PG8_WAIT_V(n) asm volatile("s_waitcnt vmcnt(" #n ")" ::: "memory")
#define PG8_WAIT_L(n) asm volatile("s_waitcnt lgkmcnt(" #n ")" ::: "memory")
#define PG8_BAR __builtin_amdgcn_s_barrier()
#define PG8_SCHED __builtin_amdgcn_sched_barrier(0)
    Unit cur, nxt; int ui = 0;
    if (!S.next(0, cur)) return;
    f32x4 acc[2][2][4][2];
#pragma unroll
    for (int a = 0; a < 2; ++a)
#pragma unroll
        for (int b = 0; b < 2; ++b)
#pragma unroll
            for (int m = 0; m < 4; ++m)
#pragma unroll
                for (int n = 0; n < 2; ++n) acc[a][b][m][n] = (f32x4){0.f, 0.f, 0.f, 0.f};
    bf16x8 At[4][2], B0[2][2], B1[2][2];
    const char* cA = (const char*)g.A + (size_t)cur.pm * tstep; const char* cB = (const char*)g.Bt + (size_t)cur.pn * tstep;
    PG8_STAGE(PG8_SB(0, 0), cB, voffB); PG8_STAGE(PG8_SA(0, 0), cA, voffA); PG8_STAGE(PG8_SB(0, 1), cB + hstep, voffB); PG8_STAGE(PG8_SA(0, 1), cA + hstep, voffA);
    if (wr == 1) PG8_BAR;
    PG8_WAIT_V(4); PG8_BAR;
    PG8_STAGE(PG8_SB(1, 0), cB + kstep, voffB); PG8_STAGE(PG8_SA(1, 0), cA + kstep, voffA); PG8_STAGE(PG8_SB(1, 1), cB + hstep + kstep, voffB);
    PG8_WAIT_V(6); PG8_BAR;
    for (;;) {
        const bool has_next = S.next(ui + 1, nxt);
        const char* nA = has_next ? (const char*)g.A + (size_t)nxt.pm * tstep : cA; const char* nB = has_next ? (const char*)g.Bt + (size_t)nxt.pn * tstep : cB;
        for (int t = 0; t < nt; t += 2) {
            const bool last = (t == nt - 2);
            const char* a1 = cA + (size_t)(t + 1) * kstep;
            const char* a2 = last ? nA : cA + (size_t)(t + 2) * kstep; const char* b2 = last ? nB : cB + (size_t)(t + 2) * kstep;
            const char* a3 = a2 + kstep; const char* b3 = b2 + kstep;
            PG8_LDB(B0, 0, 0); PG8_SCHED; PG8_LDA(At, 0, 0); PG8_STAGE(PG8_SA(1, 1), a1 + hstep, voffA);
            PG8_WAIT_L(8); PG8_BAR; PG8_WAIT_L(0); PG8_MMA(0, 0, At, B0); PG8_BAR; PG8_SCHED;
            PG8_LDB(B1, 0, 1); PG8_STAGE(PG8_SB(0, 0), b2, voffB);
            PG8_BAR; PG8_WAIT_L(0); PG8_MMA(0, 1, At, B1); PG8_BAR;
            PG8_LDA(At, 0, 1); PG8_STAGE(PG8_SA(0, 0), a2, voffA);
            PG8_BAR; PG8_WAIT_L(0); PG8_MMA(1, 0, At, B0); PG8_BAR; PG8_SCHED;
            PG8_STAGE(PG8_SB(0, 1), b2 + hstep, voffB);
            PG8_WAIT_V(6); PG8_BAR; PG8_MMA(1, 1, At, B1); PG8_BAR;
            PG8_LDB(B0, 1, 0); PG8_SCHED; PG8_LDA(At, 1, 0); PG8_STAGE(PG8_SA(0, 1), a2 + hstep, voffA);
            PG8_WAIT_L(8); PG8_BAR; PG8_WAIT_L(0); PG8_MMA(0, 0, At, B0); PG8_BAR; PG8_SCHED;
            PG8_LDB(B1, 1, 1); PG8_STAGE(PG8_SB(1, 0), b3, voffB);
            PG8_BAR; PG8_WAIT_L(0); PG8_MMA(0, 1, At, B1); PG8_BAR;
            PG8_LDA(At, 1, 1); PG8_STAGE(PG8_SA(1, 0), a3, voffA);
            PG8_BAR; PG8_WAIT_L(0); PG8_MMA(1, 0, At, B0); PG8_BAR; PG8_SCHED;
            PG8_STAGE(PG8_SB(1, 1), b3 + hstep, voffB);
            PG8_WAIT_V(6); PG8_BAR; PG8_MMA(1, 1, At, B1); PG8_BAR;
        }
        E(acc, cur, wr, wc, fr, fq);
        if (!has_next) break;
#pragma unroll
        for (int a = 0; a < 2; ++a)
#pragma unroll
            for (int b = 0; b < 2; ++b)
#pragma unroll
                for (int m = 0; m < 4; ++m)
#pragma unroll
                    for (int n = 0; n < 2; ++n) acc[a][b][m][n] = (f32x4){0.f, 0.f, 0.f, 0.f};
        cur = nxt; cA = nA; cB = nB; ++ui;
    }
    PG8_WAIT_V(0);
    if (wr == 0) PG8_BAR;
    PG8_BAR;
#undef PG8_SA
#undef PG8_SB
#undef PG8_STAGE
#undef PG8_LDA
#undef PG8_LDB
#undef PG8_MMA
#undef PG8_WAIT_V
#undef PG8_WAIT_L
#undef PG8_BAR
#undef PG8_SCHED
}

struct EpiBf16Act {
    static constexpr bool PERM = true;
    bf16_t* O; int ldc; int gelu_tiles;
    DEV void operator()(const f32x4 (&acc)[2][2][4][2], const Unit& u, int wr, int wc, int fr, int fq) const {
        const int row0 = u.pm * BM + wr * 64 + fr, col0 = u.pn * BM + wc * 32 + 8 * fq;
        const bool act = u.pn < gelu_tiles;
#pragma unroll
        for (int ai = 0; ai < 2; ++ai)
#pragma unroll
            for (int m = 0; m < 4; ++m) { bf16_t* rowp = O + (size_t)(row0 + ai * HALF + m * 16) * ldc + col0;
#pragma unroll
                for (int bj = 0; bj < 2; ++bj) { f32x4 v0 = acc[ai][bj][m][0], v1 = acc[ai][bj][m][1];
                    if (act) {
#pragma unroll
                        for (int j = 0; j < 4; ++j) { v0[j] = gelu_t(v0[j]); v1[j] = gelu_t(v1[j]); } }
                    u32x4 w; w.x = cvt_pk_bf16(v0[0], v0[1]); w.y = cvt_pk_bf16(v0[2], v0[3]); w.z = cvt_pk_bf16(v1[0], v1[1]); w.w = cvt_pk_bf16(v1[2], v1[3]);
                    *(u32x4*)(rowp + bj * HALF) = w; } }
    }
};
struct EpiPair {
    static constexpr bool PERM = true;
    bf16_t* O; int ldc; int mode; bf16_t* O0; int ldc0; int plain_tiles;
    DEV void operator()(const f32x4 (&acc)[2][2][4][2], const Unit& u, int wr, int wc, int fr, int fq) const {
        const int row0 = u.pm * BM + wr * 64 + fr;
        if (mode == 1 && u.pn < plain_tiles) {
            const int col0 = u.pn * BM + wc * 32 + 8 * fq;
#pragma unroll
            for (int ai = 0; ai < 2; ++ai)
#pragma unroll
                for (int m = 0; m < 4; ++m) { bf16_t* rowp = O0 + (size_t)(row0 + ai * HALF + m * 16) * ldc0 + col0;
#pragma unroll
                    for (int bj = 0; bj < 2; ++bj) { const f32x4 v0 = acc[ai][bj][m][0], v1 = acc[ai][bj][m][1];
                        u32x4 w; w.x = cvt_pk_bf16(v0[0], v0[1]); w.y = cvt_pk_bf16(v0[2], v0[3]); w.z = cvt_pk_bf16(v1[0], v1[1]); w.w = cvt_pk_bf16(v1[2], v1[3]);
                        *(u32x4*)(rowp + bj * HALF) = w; } }
            return;
        }
        const int pt = (mode == 1) ? (u.pn - plain_tiles) : u.pn;
        const int col0 = pt * HALF + wc * 32 + 8 * fq;
#pragma unroll
        for (int ai = 0; ai < 2; ++ai)
#pragma unroll
            for (int m = 0; m < 4; ++m) { bf16_t* rowp = O + (size_t)(row0 + ai * HALF + m * 16) * ldc + col0;
                f32x4 r0, r1;
#pragma unroll
                for (int j = 0; j < 4; ++j) {
                    const float a0 = acc[ai][0][m][0][j], a1 = acc[ai][0][m][1][j], b0 = acc[ai][1][m][0][j], b1 = acc[ai][1][m][1][j];
                    r0[j] = (mode == 0 ? silu_f(a0) : a0) * b0; r1[j] = (mode == 0 ? silu_f(a1) : a1) * b1; }
                u32x4 w; w.x = cvt_pk_bf16(r0[0], r0[1]); w.y = cvt_pk_bf16(r0[2], r0[3]); w.z = cvt_pk_bf16(r1[0], r1[1]); w.w = cvt_pk_bf16(r1[2], r1[3]);
                *(u32x4*)rowp = w; }
    }
};
struct EpiResid {
    static constexpr bool PERM = false;
    float* C; const float* R; int ldc;
    DEV void operator()(const f32x4 (&acc)[2][2][4][2], const Unit& u, int wr, int wc, int fr, int fq) const {
        const int row0 = u.pm * BM + wr * 64 + fr, col0 = u.pn * BM + wc * 32 + 4 * fq;
#pragma unroll
        for (int ai = 0; ai < 2; ++ai)
#pragma unroll
            for (int m = 0; m < 4; ++m) { const size_t ro = (size_t)(row0 + ai * HALF + m * 16) * ldc + col0;
#pragma unroll
                for (int bj = 0; bj < 2; ++bj)
#pragma unroll
                    for (int n = 0; n < 2; ++n) { const f32x4 r = *(const f32x4*)(R + ro + bj * HALF + n * 16); *(f32x4*)(C + ro + bj * HALF + n * 16) = acc[ai][bj][m][n] + r; } }
    }
};
struct EpiResidB {
    static constexpr bool PERM = true;
    bf16_t* C; const float* Rf; const bf16_t* Rb; int ldc;
    DEV void operator()(const f32x4 (&acc)[2][2][4][2], const Unit& u, int wr, int wc, int fr, int fq) const {
        const int row0 = u.pm * BM + wr * 64 + fr, col0 = u.pn * BM + wc * 32 + 8 * fq;
#pragma unroll
        for (int ai = 0; ai < 2; ++ai)
#pragma unroll
            for (int m = 0; m < 4; ++m) { const size_t ro = (size_t)(row0 + ai * HALF + m * 16) * ldc + col0;
#pragma unroll
                for (int bj = 0; bj < 2; ++bj) { f32x4 v0 = acc[ai][bj][m][0], v1 = acc[ai][bj][m][1];
                    if (Rf) { v0 += *(const f32x4*)(Rf + ro + bj * HALF); v1 += *(const f32x4*)(Rf + ro + bj * HALF + 4); }
                    else { const u32x4 r = *(const u32x4*)(Rb + ro + bj * HALF);
                        v0[0] += bf2f(r.x & 0xffffu); v0[1] += bf2f(r.x >> 16); v0[2] += bf2f(r.y & 0xffffu); v0[3] += bf2f(r.y >> 16);
                        v1[0] += bf2f(r.z & 0xffffu); v1[1] += bf2f(r.z >> 16); v1[2] += bf2f(r.w & 0xffffu); v1[3] += bf2f(r.w >> 16); }
                    u32x4 w; w.x = cvt_pk_bf16(v0[0], v0[1]); w.y = cvt_pk_bf16(v0[2], v0[3]); w.z = cvt_pk_bf16(v1[0], v1[1]); w.w = cvt_pk_bf16(v1[2], v1[3]);
                    *(u32x4*)(C + ro + bj * HALF) = w; } }
    }
};
}

template <class Epi>
DEV void run_gemm(unsigned char* shm, const bf16_t* A, const bf16_t* Bt, int M, int N, int K, const Epi& E) {
    pg8::Gemm g; g.A = A; g.Bt = Bt; g.M = M; g.N = N; g.K = K;
    pg8::StaticOrder S; S.init(M, N, (int)gridDim.x, (int)blockIdx.x);
    pg8::gemm_phase<Epi>((LAS unsigned char*)shm, g, S, E);
    __syncthreads();
}

template <class CM>
DEV void transpose_conv(unsigned char* shm, bf16_t* __restrict__ dst, int Nd, int K, int ld, const float* rowscale, const CM cm) {
    float* lt = (float*)shm;
    const int tid = threadIdx.x, tn = Nd >> 6, tk = K >> 6, ntile = tn * tk;
    const int nn = tid & 63, kq = tid >> 6;
    float r[8];
    int tile = blockIdx.x;
    if (tile < ntile) { const int n0 = (tile % tn) << 6, k0 = (tile / tn) << 6; const float* cp = cm(n0 + nn);
#pragma unroll
        for (int i = 0; i < 8; ++i) { const int kk = k0 + kq + 8 * i; float v = cp ? cp[(size_t)kk * ld] : 0.f; if (rowscale) v *= rowscale[kk]; r[i] = v; } }
    while (tile < ntile) {
        const int n0 = (tile % tn) << 6, k0 = (tile / tn) << 6;
#pragma unroll
        for (int i = 0; i < 8; ++i) lt[(kq + 8 * i) * 65 + nn] = r[i];
        __syncthreads();
        const int nxt = tile + gridDim.x;
        if (nxt < ntile) { const int n1 = (nxt % tn) << 6, k1 = (nxt / tn) << 6; const float* cp = cm(n1 + nn);
#pragma unroll
            for (int i = 0; i < 8; ++i) { const int kk = k1 + kq + 8 * i; float v = cp ? cp[(size_t)kk * ld] : 0.f; if (rowscale) v *= rowscale[kk]; r[i] = v; } }
#pragma unroll
        for (int i = 0; i < 4; ++i) { const int pi = tid + 512 * i, n2 = pi >> 5, k2 = (pi & 31) * 2;
            *(unsigned*)(dst + (size_t)(n0 + n2) * K + k0 + k2) = cvt_pk_bf16(lt[k2 * 65 + n2], lt[(k2 + 1) * 65 + n2]); }
        __syncthreads();
        tile = nxt;
    }
}
struct CmPlain { const float* src; DEV const float* operator()(int n) const { return src + n; } };
struct CmWin { const float* src;
    DEV const float* operator()(int n) const { if (n < 3840) return src + n; if (n < 4096) return src + n + 256; if (n < 4120) return src + n + 512; return nullptr; } };
struct CmWv { const float* src; DEV const float* operator()(int n) const { return n < 256 ? src + 3840 + n : src + 4352 + (n - 256); } };
struct CmGU { const float* gate; const float* up; DEV const float* operator()(int n) const { const int pn = n >> 8, bj = (n >> 7) & 1, i = n & 127; const long long diff = (const char*)up - (const char*)gate; return (const float*)((const char*)gate + (long long)bj * diff) + pn * 128 + i; } };
struct CmInC { const float* src; DEV const float* operator()(int n) const { if (n < 2048) return src + n; const int m = n - 2048, pn = m >> 8, bj = (m >> 7) & 1, i = m & 127; return src + 2048 + bj * 2048 + pn * 128 + i; } };

template <bool SRCBF>
DEV void rmsnorm_rows(const void* srcv, const float* gain, bf16_t* dst, float* dstf) {
    const int lane = threadIdx.x & 63, wv = threadIdx.x >> 6;
    f32x4 gv[8];
#pragma unroll
    for (int i = 0; i < 8; ++i) gv[i] = *(const f32x4*)(gain + (i * 64 + lane) * 4);
    const int stride = gridDim.x * 8;
    auto ld4 = [&](int row, int i) -> f32x4 {
        if (SRCBF) { const u32x2 r = *(const u32x2*)((const bf16_t*)srcv + (size_t)row * DM + (i * 64 + lane) * 4);
            return (f32x4){bf2f(r.x & 0xffffu), bf2f(r.x >> 16), bf2f(r.y & 0xffffu), bf2f(r.y >> 16)}; }
        return *(const f32x4*)((const float*)srcv + (size_t)row * DM + (i * 64 + lane) * 4);
    };
    for (int row = blockIdx.x * 8 + wv; row < T_; row += 2 * stride) {
        const int row2 = row + stride; const bool has2 = row2 < T_; const int row2c = has2 ? row2 : row;
        f32x4 v[8], u[8]; float ss = 0.f, ss2 = 0.f;
#pragma unroll
        for (int i = 0; i < 8; ++i) v[i] = ld4(row, i);
#pragma unroll
        for (int i = 0; i < 8; ++i) u[i] = ld4(row2c, i);
#pragma unroll
        for (int i = 0; i < 8; ++i) { ss += v[i][0] * v[i][0] + v[i][1] * v[i][1] + v[i][2] * v[i][2] + v[i][3] * v[i][3]; ss2 += u[i][0] * u[i][0] + u[i][1] * u[i][1] + u[i][2] * u[i][2] + u[i][3] * u[i][3]; }
#pragma unroll
        for (int o = 32; o >= 1; o >>= 1) { ss += __shfl_xor(ss, o); ss2 += __shfl_xor(ss2, o); }
        const float rs = rsqrtf(ss * (1.0f / DM) + EPS), rs2 = rsqrtf(ss2 * (1.0f / DM) + EPS);
#pragma unroll
        for (int i = 0; i < 8; ++i) { const f32x4 y = v[i] * rs * gv[i];
            if (dst) { u32x2 w; w.x = cvt_pk_bf16(y[0], y[1]); w.y = cvt_pk_bf16(y[2], y[3]); *(u32x2*)(dst + (size_t)row * DM + (i * 64 + lane) * 4) = w; }
            else *(f32x4*)(dstf + (size_t)row * DM + (i * 64 + lane) * 4) = y; }
        if (has2) {
#pragma unroll
            for (int i = 0; i < 8; ++i) { const f32x4 y = u[i] * rs2 * gv[i];
                if (dst) { u32x2 w; w.x = cvt_pk_bf16(y[0], y[1]); w.y = cvt_pk_bf16(y[2], y[3]); *(u32x2*)(dst + (size_t)row2 * DM + (i * 64 + lane) * 4) = w; }
                else *(f32x4*)(dstf + (size_t)row2 * DM + (i * 64 + lane) * 4) = y; }
        }
    }
}

DEV void phase_prep(const Params& p, unsigned char* shm) {
    const int tid = threadIdx.x;
    transpose_conv(shm, WSB(O_WIN), 4352, 2048, 4632, nullptr, CmWin{p.in[4]});
    transpose_conv(shm, WSB(O_WV), 512, 2048, 4632, nullptr, CmWv{p.in[4]});
    transpose_conv(shm, WSB(O_WOUT), 2048, 2048, 2048, nullptr, CmPlain{p.in[5]});
    transpose_conv(shm, WSB(O_WGU0), 2 * DFF, 2048, DFF, nullptr, CmGU{p.in[18], p.in[19]});
    transpose_conv(shm, WSB(O_WGU1), 2 * DFF, 2048, DFF, nullptr, CmGU{p.in[18] + (size_t)DM * DFF, p.in[19] + (size_t)DM * DFF});
    transpose_conv(shm, WSB(O_WDN0), 2048, DFF, 2048, nullptr, CmPlain{p.in[20]});
    transpose_conv(shm, WSB(O_WDN1), 2048, DFF, 2048, nullptr, CmPlain{p.in[20] + (size_t)DFF * DM});
    transpose_conv(shm, WSB(O_WINC), 6144, 2048, 6144, nullptr, CmInC{p.in[15]});
    transpose_conv(shm, WSB(O_WOUTC), 2048, 2048, 2048, nullptr, CmPlain{p.in[17]});
    transpose_conv(shm, WSB(O_W1K), 128, 4096, 128, nullptr, CmPlain{p.in[10]});
    transpose_conv(shm, WSB(O_W1V), 128, 4096, 128, nullptr, CmPlain{p.in[13]});
    transpose_conv(shm, WSB(O_W2K), 128, 128, 128, nullptr, CmPlain{p.in[11]});
    transpose_conv(shm, WSB(O_W2V), 128, 128, 128, nullptr, CmPlain{p.in[14]});
    for (int i = blockIdx.x * 512 + tid; i < 8 * 128 * 128; i += gridDim.x * 512) { const int pp = i & 127, t = (i >> 7) & 127; WSB(O_SGUW)[i] = (bf16_t)(cvt_pk_bf16(pp <= t ? p.in[6][i] : 0.f, 0.f) & 0xffffu); }
    if (blockIdx.x < 16) {
        float* red = (float*)shm;
        const int kv = blockIdx.x >> 3, sl = blockIdx.x & 7;
        const float* pe = kv ? p.in[12] : p.in[9]; const float* w1 = kv ? p.in[13] : p.in[10];
        const int e = tid & 127, part = tid >> 7; float sacc = 0.f;
        const int kb = sl * 512 + part * 128;
#pragma unroll 8
        for (int k = kb; k < kb + 128; ++k) sacc += pe[k] * w1[(size_t)k * 128 + e];
        red[part * 128 + e] = sacc; __syncthreads();
        if (tid < 128) WSF(O_CBIAS)[(kv * 8 + sl) * 128 + tid] = red[tid] + red[128 + tid] + red[256 + tid] + red[384 + tid];
        __syncthreads();
    }
    rmsnorm_rows<false>(p.in[0], p.in[1], WSB(O_HN), nullptr);
}

DEV void sgu_item(const Params& p, unsigned char* shm, int item) {
    const int tid = threadIdx.x, w = tid >> 6, lane = tid & 63, fr = lane & 15, fq = lane >> 4;
    const int g = item & 7, n = (item >> 3) & 127, b = item >> 10;
    const int tok0 = b * S_ + n * 128;
    bf16_t* vT = (bf16_t*)shm;
    float* ssq = (float*)(shm + 128 * 136 * 2);
    {
        const int prow = tid & 127, cq = tid >> 7;
        const bf16_t* vp = WSB(O_PROJ) + (size_t)(tok0 + prow) * LDP + V_OFF + g * 128 + cq * 32;
        float f[32]; float ss = 0.f;
#pragma unroll
        for (int i = 0; i < 4; ++i) { const u32x4 raw = *(const u32x4*)(vp + 8 * i);
#pragma unroll
            for (int e = 0; e < 4; ++e) { f[8 * i + 2 * e] = bf2f(raw[e] & 0xffffu); f[8 * i + 2 * e + 1] = bf2f(raw[e] >> 16); } }
#pragma unroll
        for (int e = 0; e < 32; ++e) ss += f[e] * f[e];
        ssq[cq * 128 + prow] = ss;
        __syncthreads();
        const float tot = ssq[prow] + ssq[128 + prow] + ssq[256 + prow] + ssq[384 + prow];
        const float rs = rsqrtf(tot * (1.0f / 128.0f) + EPS);
        const float* gp = p.in[8] + g * 128 + cq * 32;
#pragma unroll
        for (int e = 0; e < 32; ++e) vT[(cq * 32 + e) * 136 + prow] = (bf16_t)(cvt_pk_bf16(f[e] * rs * gp[e], 0.f) & 0xffffu);
    }
    __syncthreads();
    f32x4 acc[8];
#pragma unroll
    for (int ct = 0; ct < 8; ++ct) acc[ct] = (f32x4){0.f, 0.f, 0.f, 0.f};
    const bf16_t* Wg = WSB(O_SGUW) + (size_t)(g * 128 + 16 * w + fr) * 128;
    const int nks = (w >> 1) + 1;
    for (int ks = 0; ks < nks; ++ks) {
        const bf16x8 wf = *(const bf16x8*)(Wg + 32 * ks + 8 * fq);
#pragma unroll
        for (int ct = 0; ct < 8; ++ct) { const bf16x8 vf = *(const bf16x8*)(vT + (16 * ct + fr) * 136 + 32 * ks + 8 * fq); acc[ct] = mfma16(vf, wf, acc[ct]); }
    }
    const int t = 16 * w + fr; const float bias = p.in[7][g * 128 + t]; const size_t tok = (size_t)(tok0 + t);
#pragma unroll
    for (int ct = 0; ct < 8; ++ct) {
        const u32x2 uu = *(const u32x2*)(WSB(O_PROJ) + tok * LDP + U_OFF + g * 128 + 16 * ct + 4 * fq);
        const float y0 = bf2f(uu.x & 0xffffu) * (acc[ct][0] + bias), y1 = bf2f(uu.x >> 16) * (acc[ct][1] + bias), y2 = bf2f(uu.y & 0xffffu) * (acc[ct][2] + bias), y3 = bf2f(uu.y >> 16) * (acc[ct][3] + bias);
        u32x2 o; o.x = cvt_pk_bf16(y0, y1); o.y = cvt_pk_bf16(y2, y3);
        *(u32x2*)(WSB(O_CAT) + tok * 2048 + g * 128 + 16 * ct + 4 * fq) = o;
    }
    __syncthreads();
}

DEV void compress_item(const Params& p, unsigned char* shm, int item) {
    const int tid = threadIdx.x, w = tid >> 6, lane = tid & 63, fr = lane & 15, fq = lane >> 4;
    const int kv = item >> 7, b = (item >> 6) & 1, g = (item >> 5) & 1, n0 = (item & 31) * 32;
    float* part = (float*)shm;
    bf16_t* hid = (bf16_t*)(shm + 131072);
    const bf16_t* W1 = kv ? WSB(O_W1V) : WSB(O_W1K);
    const bf16_t* W2 = kv ? WSB(O_W2V) : WSB(O_W2K);
    const int coff = (kv ? VC_OFF : KC_OFF) + g * 128;
    {
        f32x4 acc[2][8];
#pragma unroll
        for (int ns = 0; ns < 2; ++ns)
#pragma unroll
            for (int et = 0; et < 8; ++et) acc[ns][et] = (f32x4){0.f, 0.f, 0.f, 0.f};
        for (int ks = 0; ks < 16; ++ks) {
            const int l = 4 * w + (ks >> 2), d0 = 32 * (ks & 3) + 8 * fq;
            bf16x8 af[2];
#pragma unroll
            for (int ns = 0; ns < 2; ++ns) { const int nn = n0 + 16 * ns + fr; af[ns] = *(const bf16x8*)(WSB(O_PROJ) + (size_t)(b * S_ + 16 * nn + l) * LDP + coff + d0); }
#pragma unroll
            for (int et = 0; et < 8; ++et) { const bf16x8 wf = *(const bf16x8*)(W1 + (size_t)(16 * et + fr) * 4096 + 512 * w + 32 * ks + 8 * fq);
                acc[0][et] = mfma16(wf, af[0], acc[0][et]); acc[1][et] = mfma16(wf, af[1], acc[1][et]); }
        }
#pragma unroll
        for (int ns = 0; ns < 2; ++ns)
#pragma unroll
            for (int et = 0; et < 8; ++et) *(f32x4*)(part + (size_t)w * 4096 + (16 * ns + fr) * 128 + 16 * et + 4 * fq) = acc[ns][et];
    }
    __syncthreads();
#pragma unroll
    for (int i = 0; i < 8; ++i) { const int idx = tid + 512 * i, nn = idx >> 7, e = idx & 127; float s = 0.f;
#pragma unroll
        for (int j = 0; j < 8; ++j) s += WSF(O_CBIAS)[(kv * 8 + j) * 128 + e];
#pragma unroll
        for (int ww = 0; ww < 8; ++ww) s += part[ww * 4096 + idx];
        hid[nn * 136 + e] = (bf16_t)(cvt_pk_bf16(gelu_t(s), 0.f) & 0xffffu); }
    __syncthreads();
    {
        f32x4 acc[2];
        acc[0] = acc[1] = (f32x4){0.f, 0.f, 0.f, 0.f};
#pragma unroll
        for (int ks = 0; ks < 4; ++ks) {
            const bf16x8 wf = *(const bf16x8*)(W2 + (size_t)(16 * w + fr) * 128 + 32 * ks + 8 * fq);
#pragma unroll
            for (int ns = 0; ns < 2; ++ns) { const bf16x8 hf = *(const bf16x8*)(hid + (16 * ns + fr) * 136 + 32 * ks + 8 * fq);
                acc[ns] = kv ? mfma16(hf, wf, acc[ns]) : mfma16(wf, hf, acc[ns]); }
        }
        const int bg = b * 2 + g;
#pragma unroll
        for (int ns = 0; ns < 2; ++ns) {
            if (kv == 0) {
                const int nn = n0 + 16 * ns + fr; f32x4 v = acc[ns]; if (nn >= 1023) v = (f32x4){0.f, 0.f, 0.f, 0.f};
                u32x2 o; o.x = cvt_pk_bf16(v[0], v[1]); o.y = cvt_pk_bf16(v[2], v[3]);
                *(u32x2*)(WSB(O_KCMP) + ((size_t)bg * 1024 + nn) * 128 + 16 * w + 4 * fq) = o;
            } else {
                const int nb = n0 + 16 * ns + 4 * fq; f32x4 v = acc[ns]; if (nb + 3 >= 1023) v[3] = 0.f;
                u32x2 o; o.x = cvt_pk_bf16(v[0], v[1]); o.y = cvt_pk_bf16(v[2], v[3]);
                *(u32x2*)(WSB(O_VCMPT) + ((size_t)bg * 128 + 16 * w + fr) * 1024 + nb) = o;
            }
        }
    }
    __syncthreads();
}

constexpr int KB_BYTES = 16384, VB_BYTES = 16384;
constexpr int NQS = 1, QW = 16 * NQS, QI = 2 * QW;
constexpr int A_IMP = 0, IMP_STR = 260, A_MASK = A_IMP + QI * IMP_STR * 4, A_UNI = A_MASK + QI * 8 * 4;
constexpr int A_KB0 = (A_UNI + 32 + 4095) & ~4095, A_VB0 = A_KB0 + 16384, A_KB1 = A_KB0 + 32768, A_VB1 = A_KB0 + 49152;
static_assert(A_UNI + 32 <= 65536 && A_VB1 + 16384 <= LDS_BYTES, "lds");

DEV void tile_dma(unsigned char* shm, int kboff, int vboff, const char* kp, size_t kstr, const char* vp, size_t vstr, bool withV) {
    const int tid = threadIdx.x, wid = __builtin_amdgcn_readfirstlane(tid >> 6);
    LAS unsigned char* lds = (LAS unsigned char*)shm;
#pragma unroll
    for (int i = 0; i < 2; ++i) { const int P = tid * 16 + i * 8192, row = P >> 8, c = ((P >> 4) & 15) ^ (row & 15);
        __builtin_amdgcn_global_load_lds((const unsigned*)(kp + (size_t)row * kstr + c * 16), (LAS unsigned*)(lds + kboff + wid * 1024 + i * 8192), 16, 0, 0); }
    if (withV) {
#pragma unroll
        for (int i = 0; i < 2; ++i) { const int P = tid * 16 + i * 8192, row = P >> 7, c = ((P >> 4) & 7) ^ ((row >> 1) & 7);
            __builtin_amdgcn_global_load_lds((const unsigned*)(vp + (size_t)row * vstr + c * 16), (LAS unsigned*)(lds + vboff + wid * 1024 + i * 8192), 16, 0, 0); }
    }
}
DEV int next_bit(const unsigned* uni, int from) {
    for (int w = from >> 5; w < 8; ++w) { unsigned xw = uni[w]; if (w == (from >> 5)) xw &= (~0u) << (from & 31); if (xw) return w * 32 + __builtin_ctz(xw); }
    return -1;
}

struct AttnState { f32x4 O[NQS][8]; float m[NQS], l[NQS], invl[NQS]; };

template <int BR>
DEV void attn_tile(const unsigned char* kb, const unsigned char* vb, const bf16x8 (&qf)[NQS][4], AttnState& st, int tilebase,
                   const int (&tq)[NQS], const float (&ctq)[NQS], float slope2, const bool (&qsel)[NQS], unsigned* imp, int qrow, int fr, int fq) {
    f32x4 s[NQS][4];
#pragma unroll
    for (int kt = 0; kt < 4; ++kt) {
#pragma unroll
        for (int qs = 0; qs < NQS; ++qs) s[qs][kt] = (f32x4){0.f, 0.f, 0.f, 0.f};
#pragma unroll
        for (int ks = 0; ks < 4; ++ks) {
            const bf16x8 kf = *(const bf16x8*)(kb + (16 * kt + fr) * 256 + (((4 * ks + fq) ^ fr) << 4));
#pragma unroll
            for (int qs = 0; qs < NQS; ++qs) s[qs][kt] = mfma16(kf, qf[qs][ks], s[qs][kt]);
        }
    }
    constexpr float SC = 0.08838834764831845f * 1.4426950408889634f;
    constexpr bool CMP = (BR == 1 || BR == 2);
    constexpr float NINF = -__builtin_inff();
    const float sl = CMP ? 16.0f * slope2 : slope2;
#pragma unroll
    for (int qs = 0; qs < NQS; ++qs) {
        int lim = CMP ? (((tq[qs] - 31) >> 4) - tilebase - 4 * fq) : (tq[qs] - tilebase - 4 * fq);
        if (BR == 3) lim = qsel[qs] ? lim : -1;
        const int lo = lim - 512;
        const float lb = CMP ? fmaf(slope2, 16.0f * (float)(tilebase + 4 * fq) + 15.5f, ctq[qs]) : fmaf(slope2, (float)(tilebase + 4 * fq), ctq[qs]);
        float tmax = -1e30f;
#pragma unroll
        for (int kt = 0; kt < 4; ++kt)
#pragma unroll
            for (int j = 0; j < 4; ++j) {
                const int i = 16 * kt + j;
                bool valid = i <= lim;
                if (BR == 0) valid = valid && (i > lo);
                float xv = fmaf(s[qs][kt][j], SC, fmaf(sl, (float)i, lb));
                xv = valid ? xv : -1e30f;
                s[qs][kt][j] = xv; tmax = fmaxf(tmax, xv);
            }
        if (BR == 2) {
#pragma unroll
            for (int kt = 0; kt < 4; ++kt)
#pragma unroll
                for (int j = 0; j < 4; ++j) s[qs][kt][j] = fexp2(s[qs][kt][j] - st.m[qs]) * st.invl[qs];
        } else {
            tmax = fmaxf(tmax, __shfl_xor(tmax, 16)); tmax = fmaxf(tmax, __shfl_xor(tmax, 32));
            const float mnew = fmaxf(st.m[qs], tmax);
            const float alpha = fexp2(st.m[qs] - mnew);
            st.m[qs] = mnew;
            float ls = 0.f;
#pragma unroll
            for (int kt = 0; kt < 4; ++kt)
#pragma unroll
                for (int j = 0; j < 4; ++j) { const float xv = s[qs][kt][j]; const float pv = xv > -1e29f ? fexp2(xv - mnew) : 0.f; s[qs][kt][j] = pv; ls += pv; }
            st.l[qs] = st.l[qs] * alpha + ls;
            if (BR != 1) {
#pragma unroll
                for (int dt = 0; dt < 8; ++dt) st.O[qs][dt] *= alpha;
            }
        }
    }
    if (BR == 1) return;
#pragma unroll
    for (int s2 = 0; s2 < 2; ++s2) {
        bf16x8 pf[NQS];
#pragma unroll
        for (int qs = 0; qs < NQS; ++qs) {
            u32x4 pk; pk.x = cvt_pk_bf16(s[qs][2 * s2][0], s[qs][2 * s2][1]); pk.y = cvt_pk_bf16(s[qs][2 * s2][2], s[qs][2 * s2][3]);
            pk.z = cvt_pk_bf16(s[qs][2 * s2 + 1][0], s[qs][2 * s2 + 1][1]); pk.w = cvt_pk_bf16(s[qs][2 * s2 + 1][2], s[qs][2 * s2 + 1][3]);
            pf[qs] = __builtin_bit_cast(bf16x8, pk);
        }
#pragma unroll
        for (int dt = 0; dt < 8; ++dt) {
            const unsigned char* vrow = vb + (16 * dt + fr) * 128 + (fq & 1) * 8;
            const int c0 = 4 * s2 + (fq >> 1), sw = (fr >> 1) & 7;
            const u32x2 lo = *(const u32x2*)(vrow + ((c0 ^ sw) << 4)), hi = *(const u32x2*)(vrow + (((c0 + 2) ^ sw) << 4));
            u32x4 vv; vv.x = lo.x; vv.y = lo.y; vv.z = hi.x; vv.w = hi.y;
            const bf16x8 vf = __builtin_bit_cast(bf16x8, vv);

#pragma unroll
            for (int qs = 0; qs < NQS; ++qs) st.O[qs][dt] = mfma16(vf, pf[qs], st.O[qs][dt]);
        }
    }
    if (BR == 2) {
#pragma unroll
        for (int qs = 0; qs < NQS; ++qs) {
            unsigned* ip = imp + (qrow + 16 * qs) * IMP_STR + (tilebase >> 2) + fq;
#pragma unroll
            for (int kt = 0; kt < 4; ++kt) {
                const float p0 = s[qs][kt][0], p1 = s[qs][kt][1], p2 = s[qs][kt][2], p3 = s[qs][kt][3];
                const unsigned ua = (unsigned)(fmaf(2.0f, p0 + p1 + p2, p3) * 268435456.0f + 0.5f), uc = (unsigned)(p3 * 268435456.0f + 0.5f);
                const int J = (tilebase >> 2) + 4 * kt + fq;
                atomicAdd(ip + 4 * kt, ua);
                atomicAdd(ip + 4 * kt + (J + 1 < 256 ? 1 : 0), J + 1 < 256 ? uc : 0u);
            }
        }
    }
}

struct AttnItem { int b, g, t0; };

template <int BR>
DEV void attn_branch(const Params& p, unsigned char* shm, const AttnItem it, const bf16x8 (&qf)[NQS][4], AttnState& st,
                     const int (&tq)[NQS], const float (&ctq)[NQS], float slope2, int first_or_cnt) {
    const int tid = threadIdx.x, lane = tid & 63, fr = lane & 15, fq = lane >> 4, w = tid >> 6, wq = w & 1;
    const unsigned* uni = (const unsigned*)(shm + A_UNI);
    const unsigned* mask = (const unsigned*)(shm + A_MASK);
    unsigned* imp = (unsigned*)(shm + A_IMP);
    const bool withV = (BR != 1);
    const int bg = it.b * 2 + it.g;
    const int qrow = wq * QW + fr;
    int cur;
    if (BR == 0) cur = first_or_cnt; else if (BR == 3) cur = next_bit(uni, 0); else cur = 0;
    auto nexttile = [&](int c) -> int {
        if (BR == 0) return c + 1 <= 8 ? c + 1 : -1;
        if (BR == 3) return next_bit(uni, c + 1);
        return c + 1 < first_or_cnt ? c + 1 : -1;
    };
    auto tbase = [&](int c) -> int { return BR == 0 ? (it.t0 & ~63) - 512 + 64 * c : 64 * c; };
    auto kptr = [&](int c) -> const char* {
        if (BR == 0) return (const char*)(WSB(O_PROJ) + (size_t)(it.b * S_ + tbase(c)) * LDP + KW_OFF + it.g * 128);
        if (BR == 3) return (const char*)(WSB(O_PROJ) + (size_t)(it.b * S_ + tbase(c)) * LDP + KS_OFF + it.g * 128);
        return (const char*)(WSB(O_KCMP) + ((size_t)bg * 1024 + tbase(c)) * 128);
    };
    auto vptr = [&](int c) -> const char* {
        if (BR == 0) return (const char*)(WSB(O_VT) + (size_t)(256 + it.g * 128) * T_ + it.b * S_ + tbase(c));
        if (BR == 3) return (const char*)(WSB(O_VT) + (size_t)(it.g * 128) * T_ + it.b * S_ + tbase(c));
        return (const char*)(WSB(O_VCMPT) + (size_t)bg * 128 * 1024 + tbase(c));
    };
    const size_t kstr = (BR == 0 || BR == 3) ? (size_t)LDP * 2 : 256, vstr = (BR == 0 || BR == 3) ? (size_t)T_ * 2 : 2048;
    if (cur < 0) return;
    tile_dma(shm, A_KB0, A_VB0, kptr(cur), kstr, vptr(cur), vstr, withV);
    asm volatile("s_waitcnt vmcnt(0)" ::: "memory");
    __syncthreads();
    int buf = 0;
    while (cur >= 0) {
        const int nxt = nexttile(cur);
        if (nxt >= 0) tile_dma(shm, buf ? A_KB0 : A_KB1, buf ? A_VB0 : A_VB1, kptr(nxt), kstr, vptr(nxt), vstr, withV);
        bool qsel[NQS]; bool anysel = false;
#pragma unroll
        for (int qs = 0; qs < NQS; ++qs) qsel[qs] = true;
        bool run = true;
        if (BR == 3) {
#pragma unroll
            for (int qs = 0; qs < NQS; ++qs) { qsel[qs] = (mask[(qrow + 16 * qs) * 8 + (cur >> 5)] >> (cur & 31)) & 1u; anysel = anysel | qsel[qs]; }
            run = __any((int)anysel) != 0;
        }
        if (run) attn_tile<BR>(shm + (buf ? A_KB1 : A_KB0), shm + (buf ? A_VB1 : A_VB0), qf, st, tbase(cur), tq, ctq, slope2, qsel, imp, qrow, fr, fq);
        asm volatile("s_waitcnt vmcnt(0)" ::: "memory");
        __syncthreads();
        cur = nxt; buf ^= 1;
    }
}

template <int MODE>
DEV void attn_store(const Params& p, const AttnItem it, const AttnState& st, const float (&scl)[NQS], int h, int wq, int fr, int fq) {
#pragma unroll
    for (int qs = 0; qs < NQS; ++qs) {
        const size_t tok = (size_t)(it.b * S_ + it.t0 + wq * QW + 16 * qs + fr);
        float* yp = WSF(O_YPART) + tok * 1024 + h * 128 + 4 * fq;
#pragma unroll
        for (int dt = 0; dt < 8; ++dt) {
            f32x4 v = st.O[qs][dt] * scl[qs];
            if (MODE == 3) { u32x2 w3; w3.x = cvt_pk_bf16(v[0], v[1]); w3.y = cvt_pk_bf16(v[2], v[3]); *(u32x2*)(WSB(O_CAT) + tok * 2048 + 1024 + h * 128 + 16 * dt + 4 * fq) = w3; }
            else if (MODE == 0) *(f32x4*)(yp + 16 * dt) = v;
            else if (MODE == 1) { const f32x4 o = *(const f32x4*)(yp + 16 * dt); *(f32x4*)(yp + 16 * dt) = o + v; }
            else { const f32x4 o = *(const f32x4*)(yp + 16 * dt); v += o; u32x2 w2; w2.x = cvt_pk_bf16(v[0], v[1]); w2.y = cvt_pk_bf16(v[2], v[3]);
                *(u32x2*)(WSB(O_CAT) + tok * 2048 + 1024 + h * 128 + 16 * dt + 4 * fq) = w2; }
        }
    }
}

DEV void attn_setup(const Params& p, const AttnItem it, bf16x8 (&qf)[NQS][4], int (&tq)[NQS], float (&ctq)[NQS], float& slope2, int& h, int& wq, int fr, int fq) {
    const int w = threadIdx.x >> 6; wq = w & 1; const int r = w >> 1; h = it.g * 4 + r;
    slope2 = fexp2(-(float)(h + 1)) * 1.4426950408889634f;
#pragma unroll
    for (int qs = 0; qs < NQS; ++qs) {
        tq[qs] = it.t0 + wq * QW + 16 * qs + fr; ctq[qs] = -slope2 * (float)tq[qs];
        const bf16_t* qp = WSB(O_PROJ) + (size_t)(it.b * S_ + tq[qs]) * LDP + Q_OFF + h * 128 + 8 * fq;
#pragma unroll
        for (int ks = 0; ks < 4; ++ks) qf[qs][ks] = *(const bf16x8*)(qp + 32 * ks);
    }
}
DEV void attn_reset(AttnState& st) {
#pragma unroll
    for (int qs = 0; qs < NQS; ++qs) { st.m[qs] = -1e30f; st.l[qs] = 0.f; st.invl[qs] = 0.f;
#pragma unroll
        for (int dt = 0; dt < 8; ++dt) st.O[qs][dt] = (f32x4){0.f, 0.f, 0.f, 0.f}; }
}
DEV float gate_of(const Params& p, const AttnItem it, int tqv, int h, int br) { return sigmoid_f(bf2f(WSB(O_PROJ)[(size_t)(it.b * S_ + tqv) * LDP + GT_OFF + h * 3 + br])); }
DEV void attn_finish_l(AttnState& st) {
#pragma unroll
    for (int qs = 0; qs < NQS; ++qs) { float lt = st.l[qs]; lt += __shfl_xor(lt, 16); lt += __shfl_xor(lt, 32); st.invl[qs] = lt > 0.f ? 1.0f / lt : 0.f; }
}

DEV void window_item(const Params& p, unsigned char* shm, int item) {
    const int lane = threadIdx.x & 63, fr = lane & 15, fq = lane >> 4;
    constexpr int NQT = S_ / QI;
    AttnItem it; it.b = item / (2 * NQT); it.g = (item / NQT) & 1; const int qt = item % NQT; it.t0 = qt * QI;
    bf16x8 qf[NQS][4]; int tq[NQS]; float ctq[NQS]; float slope2; int h, wq;
    attn_setup(p, it, qf, tq, ctq, slope2, h, wq, fr, fq);
    AttnState st; attn_reset(st);
    attn_branch<0>(p, shm, it, qf, st, tq, ctq, slope2, (it.t0 >> 6) >= 8 ? 0 : 8 - (it.t0 >> 6));
    attn_finish_l(st);
    float scl[NQS];
#pragma unroll
    for (int qs = 0; qs < NQS; ++qs) scl[qs] = st.invl[qs] * gate_of(p, it, tq[qs], h, 2);
    attn_store<0>(p, it, st, scl, h, wq, fr, fq);
}

DEV void cmpsel_item(const Params& p, unsigned char* shm, int item) {
    const int tid = threadIdx.x, lane = tid & 63, fr = lane & 15, fq = lane >> 4, w = tid >> 6;
    constexpr int NQT = S_ / QI;
    AttnItem it; const int combo = item & 3, qt = NQT - 1 - (item >> 2); it.b = combo >> 1; it.g = combo & 1; it.t0 = qt * QI;
    unsigned* imp = (unsigned*)(shm + A_IMP); unsigned* mask = (unsigned*)(shm + A_MASK); unsigned* uni = (unsigned*)(shm + A_UNI);
    for (int i = tid; i < QI * IMP_STR; i += 512) imp[i] = 0u;
    if (tid < 8) uni[tid] = 0u;
    bf16x8 qf[NQS][4]; int tq[NQS]; float ctq[NQS]; float slope2; int h, wq;
    attn_setup(p, it, qf, tq, ctq, slope2, h, wq, fr, fq);
    AttnState st; attn_reset(st);
    int cnt = (it.t0 + QI - 32) / 16 + 1; if (cnt > 1024) cnt = 1024; const int ntile = (cnt + 63) >> 6;
#ifndef PROBE_NO_CMP
    attn_branch<1>(p, shm, it, qf, st, tq, ctq, slope2, ntile);
    attn_finish_l(st);
    attn_branch<2>(p, shm, it, qf, st, tq, ctq, slope2, ntile);
#endif
    f32x4 Oc[NQS][8];
#pragma unroll
    for (int qs = 0; qs < NQS; ++qs) { const float gc = gate_of(p, it, tq[qs], h, 0);
#pragma unroll
        for (int dt = 0; dt < 8; ++dt) Oc[qs][dt] = st.O[qs][dt] * gc; }
    {
        constexpr int NQW = QI / 8;
        unsigned val[NQW][4]; bool cz[NQW][4]; unsigned thr[NQW];
#pragma unroll
        for (int qi = 0; qi < NQW; ++qi) {
            const int q = w * NQW + qi, t = it.t0 + q, cur = t >> 6;
            const u32x4 v = *(const u32x4*)(imp + q * IMP_STR + 4 * lane);
            thr[qi] = 0u;
#pragma unroll
            for (int i = 0; i < 4; ++i) { const int J = 4 * lane + i; const bool forced = (J == 0) | (J == cur) | (J == cur - 1);
                val[qi][i] = forced ? 0xFFFFFFFFu : v[i]; cz[qi][i] = J <= cur; }
        }
        for (int bit = 31; bit >= 0; --bit) {
#pragma unroll
            for (int qi = 0; qi < NQW; ++qi) {
                const unsigned cand = thr[qi] | (1u << bit); int cnt = 0;
#pragma unroll
                for (int i = 0; i < 4; ++i) cnt += __popcll(__ballot(cz[qi][i] && val[qi][i] >= cand));
                thr[qi] = cnt >= 16 ? cand : thr[qi];
            }
        }
#pragma unroll
        for (int qi = 0; qi < NQW; ++qi) {
            int cgt = 0; unsigned long long be[4]; bool gt[4], eq[4];
#pragma unroll
            for (int i = 0; i < 4; ++i) { gt[i] = cz[qi][i] && val[qi][i] > thr[qi]; eq[i] = cz[qi][i] && val[qi][i] == thr[qi]; cgt += __popcll(__ballot(gt[i])); be[i] = __ballot(eq[i]); }
            const int r = 16 - cgt;
            int rank = 0;
#pragma unroll
            for (int i = 0; i < 4; ++i) rank += (int)__builtin_amdgcn_mbcnt_hi((unsigned)(be[i] >> 32), __builtin_amdgcn_mbcnt_lo((unsigned)be[i], 0u));
            unsigned nib = 0u;
#pragma unroll
            for (int i = 0; i < 4; ++i) { const bool sel = gt[i] || (eq[i] && rank < r); nib |= sel ? (1u << i) : 0u; rank += eq[i] ? 1 : 0; }
            unsigned x = nib << (4 * (lane & 7));
            x |= __shfl_xor(x, 1); x |= __shfl_xor(x, 2); x |= __shfl_xor(x, 4);
            mask[(w * NQW + qi) * 8 + (lane >> 3)] = x;
        }
    }
    __syncthreads();
    if (tid < QI * 8) atomicOr(uni + (tid & 7), mask[tid]);
    __syncthreads();
    attn_reset(st);
    attn_branch<3>(p, shm, it, qf, st, tq, ctq, slope2, 0);
    attn_finish_l(st);
    {
#pragma unroll
        for (int qs = 0; qs < NQS; ++qs) { const float gs = st.invl[qs] * gate_of(p, it, tq[qs], h, 1);
#pragma unroll
            for (int dt = 0; dt < 8; ++dt) Oc[qs][dt] = st.O[qs][dt] * gs + Oc[qs][dt]; }
        attn_reset(st);
        attn_branch<0>(p, shm, it, qf, st, tq, ctq, slope2, (it.t0 >> 6) >= 8 ? 0 : 8 - (it.t0 >> 6));
        attn_finish_l(st);
        float scl[NQS];
#pragma unroll
        for (int qs = 0; qs < NQS; ++qs) { const float gw = st.invl[qs] * gate_of(p, it, tq[qs], h, 2); scl[qs] = 1.0f;
#pragma unroll
            for (int dt = 0; dt < 8; ++dt) st.O[qs][dt] = st.O[qs][dt] * gw + Oc[qs][dt]; }
        attn_store<3>(p, it, st, scl, h, wq, fr, fq);
    }
    __syncthreads();
}

DEV void phase_conv(const Params& p) {
    const size_t nvec = (size_t)T_ * DM / 8;
    for (size_t i = (size_t)blockIdx.x * 512 + threadIdx.x; i < nvec; i += (size_t)gridDim.x * 512) {
        const size_t tok = i >> 8; const int c0 = (int)(i & 255) * 8; const int s = (int)(tok & (S_ - 1));
        const u32x4 z2 = *(const u32x4*)(WSB(O_ZZ) + tok * DM + c0);
        u32x4 z1 = (u32x4){0u, 0u, 0u, 0u}, z0 = (u32x4){0u, 0u, 0u, 0u};
        if (s >= 1) z1 = *(const u32x4*)(WSB(O_ZZ) + (tok - 1) * DM + c0);
        if (s >= 2) z0 = *(const u32x4*)(WSB(O_ZZ) + (tok - 2) * DM + c0);
        const u32x4 bgv = *(const u32x4*)(WSB(O_BG) + tok * DM + c0);
        float r[8];
#pragma unroll
        for (int e = 0; e < 8; ++e) {
            const int c = c0 + e; const unsigned sh = (e & 1) ? 16u : 0u;
            const float a0 = bf2f((z0[e >> 1] >> sh) & 0xffffu), a1 = bf2f((z1[e >> 1] >> sh) & 0xffffu), a2 = bf2f((z2[e >> 1] >> sh) & 0xffffu), bb = bf2f((bgv[e >> 1] >> sh) & 0xffffu);
            r[e] = bb * (p.in[16][c] * a0 + p.in[16][DM + c] * a1 + p.in[16][2 * DM + c] * a2);
        }
        u32x4 o; o.x = cvt_pk_bf16(r[0], r[1]); o.y = cvt_pk_bf16(r[2], r[3]); o.z = cvt_pk_bf16(r[4], r[5]); o.w = cvt_pk_bf16(r[6], r[7]);
        *(u32x4*)(WSB(O_MIX) + tok * DM + c0) = o;
    }
}

DEV void grid_barrier(unsigned* ctr, unsigned& nbar) {
    asm volatile("s_waitcnt vmcnt(0) lgkmcnt(0)" ::: "memory");
    __syncthreads();
    if (threadIdx.x == 0) {
        __builtin_amdgcn_fence(__ATOMIC_RELEASE, "agent");
        asm volatile("s_waitcnt vmcnt(0)" ::: "memory");
        __hip_atomic_fetch_add(ctr, 1u, __ATOMIC_RELAXED, __HIP_MEMORY_SCOPE_AGENT);
        const unsigned target = (nbar + 1u) * gridDim.x;
        while (__hip_atomic_load(ctr, __ATOMIC_RELAXED, __HIP_MEMORY_SCOPE_AGENT) < target) __builtin_amdgcn_s_sleep(1);
        __builtin_amdgcn_fence(__ATOMIC_ACQUIRE, "agent");
        asm volatile("s_waitcnt vmcnt(0)" ::: "memory");
    }
    __syncthreads();
    ++nbar;
}

__global__ void __launch_bounds__(512, 2) mega(Params p, int ph_lo, int ph_hi, int coop) {
    extern __shared__ __attribute__((aligned(16))) unsigned char shm[];
    cg::grid_group grid = cg::this_grid();
#ifdef DIAG_MASK
    unsigned long long tprev_ = __builtin_amdgcn_s_memrealtime(); float accms_ = 0.f;
#define DIAG_TICK(n) { const unsigned long long now_ = __builtin_amdgcn_s_memrealtime(); if (((DIAG_MASK) >> (n)) & 1) accms_ += (float)(now_ - tprev_) * 1e-5f; tprev_ = now_; }
#else
#define DIAG_TICK(n)
#endif
#define PH_BEGIN(n) if (ph_lo <= (n) && (n) < ph_hi) {
#define PH_END(n) } if (coop && ph_lo <= (n) && (n) + 1 < ph_hi) { \
        if ((n) == 0) { asm volatile("s_waitcnt vmcnt(0) lgkmcnt(0)" ::: "memory"); grid.sync(); __builtin_amdgcn_fence(__ATOMIC_ACQUIRE, "agent"); asm volatile("s_waitcnt vmcnt(0)" ::: "memory"); } \
        else grid_barrier(bar_, nbar_); \
        DIAG_TICK(n) }
    unsigned* bar_ = (unsigned*)(p.ws + WS_END); unsigned nbar_ = 0u;
    PH_BEGIN(0) phase_prep(p, shm); PH_END(0)
    PH_BEGIN(1)
        pg8::EpiBf16Act e1; e1.O = WSB(O_PROJ); e1.ldc = LDP; e1.gelu_tiles = 8;
        run_gemm(shm, WSB(O_HN), WSB(O_WIN), T_, LDP, DM, e1);
        pg8::EpiBf16Act e2; e2.O = WSB(O_VT); e2.ldc = T_; e2.gelu_tiles = 0;
        run_gemm(shm, WSB(O_WV), WSB(O_HN), 512, T_, DM, e2);
    PH_END(1)
    PH_BEGIN(2)
        for (int it = blockIdx.x; it < 256; it += gridDim.x) compress_item(p, shm, it);
        for (int it = blockIdx.x; it < 2048; it += gridDim.x) sgu_item(p, shm, it);
    PH_END(2)
    PH_BEGIN(3)
        unsigned* qctr = (unsigned*)(p.ws + WS_END) + 16; int* qslot = (int*)(shm + A_UNI + 32);
        for (;;) {
            if (threadIdx.x == 0) *qslot = (int)__hip_atomic_fetch_add(qctr, 1u, __ATOMIC_RELAXED, __HIP_MEMORY_SCOPE_AGENT);
            __syncthreads();
            const int item = *qslot;
            __syncthreads();
            if (item >= 4 * (S_ / QI)) break;
            cmpsel_item(p, shm, item);
        }
    PH_END(3)
    PH_BEGIN(4) pg8::EpiResidB e; e.C = WSB(O_HRES); e.Rf = p.in[0]; e.Rb = nullptr; e.ldc = DM; run_gemm(shm, WSB(O_CAT), WSB(O_WOUT), T_, DM, DM, e); PH_END(4)
    PH_BEGIN(5) rmsnorm_rows<true>(WSB(O_HRES), p.in[2], WSB(O_HN), nullptr); PH_END(5)
    PH_BEGIN(6) pg8::EpiPair e; e.O = WSB(O_ACT); e.ldc = DFF; e.mode = 0; e.O0 = nullptr; e.ldc0 = 0; e.plain_tiles = 0; run_gemm(shm, WSB(O_HN), WSB(O_WGU0), T_, 2 * DFF, DM, e); PH_END(6)
    PH_BEGIN(7) pg8::EpiResidB e; e.C = WSB(O_HRES); e.Rf = nullptr; e.Rb = WSB(O_HRES); e.ldc = DM; run_gemm(shm, WSB(O_ACT), WSB(O_WDN0), T_, DM, DFF, e); PH_END(7)
    PH_BEGIN(8) rmsnorm_rows<true>(WSB(O_HRES), p.in[1] + DM, WSB(O_HN), nullptr); PH_END(8)
    PH_BEGIN(9) pg8::EpiPair e; e.O = WSB(O_ZZ); e.ldc = DM; e.mode = 1; e.O0 = WSB(O_BG); e.ldc0 = DM; e.plain_tiles = 8; run_gemm(shm, WSB(O_HN), WSB(O_WINC), T_, 6144, DM, e); PH_END(9)
    PH_BEGIN(10) phase_conv(p); PH_END(10)
    PH_BEGIN(11) pg8::EpiResidB e; e.C = WSB(O_HRES); e.Rf = nullptr; e.Rb = WSB(O_HRES); e.ldc = DM; run_gemm(shm, WSB(O_MIX), WSB(O_WOUTC), T_, DM, DM, e); PH_END(11)
    PH_BEGIN(12) rmsnorm_rows<true>(WSB(O_HRES), p.in[2] + DM, WSB(O_HN), nullptr); PH_END(12)
    PH_BEGIN(13) pg8::EpiPair e; e.O = WSB(O_ACT); e.ldc = DFF; e.mode = 0; e.O0 = nullptr; e.ldc0 = 0; e.plain_tiles = 0; run_gemm(shm, WSB(O_HN), WSB(O_WGU1), T_, 2 * DFF, DM, e); PH_END(13)
    PH_BEGIN(14) pg8::EpiResidB e; e.C = WSB(O_HRES); e.Rf = nullptr; e.Rb = WSB(O_HRES); e.ldc = DM; run_gemm(shm, WSB(O_ACT), WSB(O_WDN1), T_, DM, DFF, e); PH_END(14)
    PH_BEGIN(15) rmsnorm_rows<true>(WSB(O_HRES), p.in[3], nullptr, p.out); PH_END(15)
#ifdef DIAG_MASK
    if (blockIdx.x == 0 && threadIdx.x == 0) p.out[0] += accms_;
#endif
#ifdef DUMP_OFF
    if (ph_hi < 16) { __builtin_amdgcn_fence(__ATOMIC_RELEASE, "agent"); grid.sync(); __builtin_amdgcn_fence(__ATOMIC_ACQUIRE, "agent");
        const size_t half = (size_t)T_ * 1024;
        for (size_t i = (size_t)blockIdx.x * 512 + threadIdx.x; i < 2 * half; i += (size_t)gridDim.x * 512) {
            float v;
            v = bf2f(WSB(O_CAT)[i]);
            p.out[i] = v; } }
#endif
}
constexpr int NPHASE = 16;

extern "C" void kernel_launch(void* const* d_in, const int* in_sizes, int n_in, void* d_out, int out_size, void* d_ws, size_t ws_size, hipStream_t stream) {
    static int grid_blocks = 0;
    if (!grid_blocks) {
        int dev = 0, cus = 0, per_cu = 0;
        hipGetDevice(&dev);
        hipDeviceGetAttribute(&cus, hipDeviceAttributeMultiprocessorCount, dev);
        hipFuncSetAttribute((const void*)mega, hipFuncAttributeMaxDynamicSharedMemorySize, LDS_BYTES);
        hipOccupancyMaxActiveBlocksPerMultiprocessor(&per_cu, (const void*)mega, 512, LDS_BYTES);
        if (per_cu < 1) { fprintf(stderr, "occupancy query returned %d\n", per_cu); per_cu = 1; }
        grid_blocks = cus * per_cu;
        (void)hipGetLastError();
    }
    Params p{};
    for (int i = 0; i < 21; ++i) p.in[i] = (const float*)d_in[i];
    p.out = (float*)d_out; p.ws = (unsigned char*)d_ws;
    if (WS_NEED > ws_size || n_in != 21) { fprintf(stderr, "workspace too small / bad inputs: need %zu have %zu, n_in %d\n", (size_t)WS_END, ws_size, n_in); return; }
    #ifdef DUMP_HI
    int lo = 0, hi = DUMP_HI, coop = 1;
#else
    int lo = 0, hi = NPHASE, coop = 1;
#endif
    (void)hipMemsetAsync((unsigned char*)d_ws + WS_END, 0, 256, stream);
    void* args[] = {&p, &lo, &hi, &coop};
    hipError_t e = hipLaunchCooperativeKernel((const void*)mega, dim3(grid_blocks), dim3(512), args, LDS_BYTES, stream);
    if (e != hipSuccess) fprintf(stderr, "cooperative launch failed: %s (grid %d)\n", hipGetErrorString(e), grid_blocks);
}
```
